# Optimizing an MI355X kernel written in HIP

```python
import math
import jax, jax.numpy as jnp
from jax import lax
import numpy as np

D_MODEL = 2048
BATCH = 2
SEQ = 4096
DEPTH = 4
DEC_BATCH = 32
DEC_SEQ = 8
PAST_LEN = 16384
PAGE_SIZE = 128

N_EVEN = (DEPTH + 1) // 2
N_ODD = DEPTH // 2

A_WIDTH = D_MODEL // 2
A_HEADS = 8
A_KDIM = 128
A_VDIM = A_WIDTH // A_HEADS
A_QK = A_HEADS * A_KDIM
A_CHUNK = 64
B_HEADS = 16
B_HEAD_DIM = 64
B_KV_HEADS = 4
B_GROUP = B_HEADS // B_KV_HEADS
B_WIDTH = B_HEADS * B_HEAD_DIM
B_KV_WIDTH = B_KV_HEADS * B_HEAD_DIM
WINDOW = 128
N_BUCKETS = 32
MAX_DISTANCE = 128
MASK_VALUE = -1e30
IN_A = 2 * A_QK + 2 * A_WIDTH
IN_EVEN = IN_A + B_WIDTH + 2 * B_KV_WIDTH
EVEN_SPLITS = (A_QK, 2 * A_QK, 2 * A_QK + A_WIDTH, IN_A, IN_A + B_WIDTH, IN_A + B_WIDTH + B_KV_WIDTH)
MIX_WIDTH = A_WIDTH + B_WIDTH
C_HEAD = 64
C_HEADS = D_MODEL // C_HEAD
LORA_DECAY = 96
LORA_AAA = 96
LORA_MV = 64
LORA_GATE = 256
GN_EPS = 64e-5
D_FF = 4 * D_MODEL
NORM_EPS = 1e-6

kernel_name = "hgrn2_swa_sink_rwkv7_hybrid_step"

F32 = jnp.float32


def rmsnorm(x, g):
    xf = x.astype(F32)
    y = xf * lax.rsqrt(jnp.mean(xf * xf, axis=-1, keepdims=True) + NORM_EPS)
    return (y * g.astype(F32)).astype(x.dtype)


def hgrn_lower_bounds(lb_raw):
    p = jax.nn.softmax(lb_raw.astype(F32), axis=0)
    return jnp.cumsum(p, axis=0) - p[0]


def gla_chunked(q, k, v, logf, s0):
    B, L, H, K = q.shape
    C = math.gcd(L, A_CHUNK)
    N = L // C
    def to_chunks(t):
        return t.reshape(B, N, C, H, t.shape[-1]).transpose(1, 0, 3, 2, 4)
    causal = jnp.tril(jnp.ones((C, C), bool))[:, :, None]
    def step(S, inp):
        qi, ki, vi, gi = inp
        G = jnp.cumsum(gi, axis=2)
        diff = G[:, :, :, None, :] - G[:, :, None, :, :]
        decay = jnp.where(causal, jnp.exp(jnp.minimum(diff, 0.0)), 0.0)
        attn = jnp.einsum("bhik,bhjk,bhijk->bhij", qi, ki, decay)
        o = jnp.einsum("bhij,bhjv->bhiv", attn, vi) + jnp.einsum("bhik,bhkv->bhiv", qi * jnp.exp(G), S)
        g_last = G[:, :, -1, :]
        S_new = jnp.exp(g_last)[..., None] * S + jnp.einsum("bhjk,bhjv->bhkv", ki * jnp.exp(g_last[:, :, None, :] - G), vi)
        return S_new, o
    S, o = lax.scan(step, s0, (to_chunks(q), to_chunks(k), to_chunks(v), to_chunks(logf)))
    o = o.transpose(1, 0, 3, 2, 4).reshape(B, L, H, v.shape[-1])
    return o, S


def t5_bucket(dist):
    max_exact = N_BUCKETS // 2
    d = np.maximum(dist, 0)
    large = max_exact + (np.log(np.maximum(d, max_exact).astype(np.float32) / max_exact)
                         / math.log(MAX_DISTANCE / max_exact) * (N_BUCKETS - max_exact)).astype(np.int32)
    large = np.minimum(large, N_BUCKETS - 1)
    return np.where(d < max_exact, d, large).astype(np.int32)


def swa_sinks(q, k_all, v_all, pos0, rel_bias, sinks):
    B, L, H, D = q.shape
    P = k_all.shape[1] - L
    pad = WINDOW - P
    k_pad = jnp.pad(k_all, ((0, 0), (pad, 0), (0, 0), (0, 0)))
    v_pad = jnp.pad(v_all, ((0, 0), (pad, 0), (0, 0), (0, 0)))
    QB = math.gcd(L, WINDOW)
    NB = L // QB
    span = WINDOW + QB
    idx = np.arange(NB)[:, None] * QB + np.arange(span)[None, :]
    kb = k_pad[:, idx]
    vb = v_pad[:, idx]
    qb = q.reshape(B, NB, QB, B_KV_HEADS, B_GROUP, D)
    dist = np.arange(QB)[:, None] + WINDOW - np.arange(span)[None, :]
    key_pos = pos0 - WINDOW + idx
    valid = (dist >= 0)[None] & (dist < WINDOW)[None] & (key_pos[:, None, :] >= 0)
    bias = rel_bias.astype(F32)[t5_bucket(dist)]
    bias = bias.transpose(2, 0, 1).reshape(B_KV_HEADS, B_GROUP, QB, span)
    s = jnp.einsum("bnqkgd,bnskd->bnkgqs", qb, kb).astype(F32) * (D ** -0.5) + bias
    s = jnp.where(valid[None, :, None, None], s, MASK_VALUE)
    sink = sinks.astype(F32).reshape(B_KV_HEADS, B_GROUP)[None, None, :, :, None, None]
    m = jnp.maximum(jnp.max(s, axis=-1, keepdims=True), sink)
    p = jnp.exp(s - m)
    p = p / (jnp.sum(p, axis=-1, keepdims=True) + jnp.exp(sink - m))
    o = jnp.einsum("bnkgqs,bnskd->bnqkgd", p.astype(vb.dtype), vb)
    return o.reshape(B, L, H * D)


def even_mixer(h, lb, s0, k_past, v_past, pos0, w_in, a_norm_g, rel_bias, sinks, w_out):
    B, L, _ = h.shape
    proj = h @ w_in
    q_a, f_a, i_a, g_a, q_b, k_b, v_b = jnp.split(proj, EVEN_SPLITS, axis=-1)
    fq = f_a.astype(F32).reshape(B, L, A_HEADS, A_KDIM)
    lbh = lb.reshape(A_HEADS, A_KDIM)
    f = lbh + (1.0 - lbh) * jax.nn.sigmoid(fq)
    logf = jnp.log(f)
    kk = (1.0 - lbh) * jax.nn.sigmoid(-fq)
    qq = jax.nn.silu(q_a.astype(F32)).reshape(B, L, A_HEADS, A_KDIM) * (A_KDIM ** -0.5)
    vv = i_a.astype(F32).reshape(B, L, A_HEADS, A_VDIM)
    o_a, s_new = gla_chunked(qq, kk, vv, logf, s0.astype(F32))
    o_a = (rmsnorm(o_a.reshape(B, L, A_WIDTH), a_norm_g) * jax.nn.silu(g_a.astype(F32))).astype(h.dtype)
    qb = q_b.reshape(B, L, B_HEADS, B_HEAD_DIM)
    k_all = jnp.concatenate([k_past.astype(h.dtype), k_b.reshape(B, L, B_KV_HEADS, B_HEAD_DIM)], axis=1)
    v_all = jnp.concatenate([v_past.astype(h.dtype), v_b.reshape(B, L, B_KV_HEADS, B_HEAD_DIM)], axis=1)
    o_b = swa_sinks(qb, k_all, v_all, pos0, rel_bias, sinks).astype(h.dtype)
    out = jnp.concatenate([o_a, o_b], axis=-1) @ w_out
    return out, s_new, k_all[:, -WINDOW:], v_all[:, -WINDOW:]


def rwkv7_mixer(h, shift0, S0, v_first, vres, mu, wr, wk, wv, wo, w0, w1, w2, a0, a1, a2, g1, g2, k_k, k_a, r_k, lnx_g, lnx_b):
    B, L, D = h.shape
    H, N = C_HEADS, C_HEAD
    x_prev = jnp.concatenate([shift0[:, None, :].astype(h.dtype), h[:, :-1]], axis=1)
    xx = x_prev - h
    xr, xw, xk, xv, xa, xg = [h + xx * mu[i] for i in range(6)]
    r = xr @ wr
    k = xk @ wk
    v = xv @ wv
    v_layer = v
    if vres is not None:
        v0, v1, v2 = vres
        v = v + (v_first - v) * jax.nn.sigmoid(v0 + (xv @ v1) @ v2)
    w_log = -jax.nn.softplus(-(w0 + jnp.tanh(xw @ w1) @ w2).astype(F32)) - 0.5
    a = jax.nn.sigmoid((a0 + (xa @ a1) @ a2).astype(F32))
    g = jax.nn.sigmoid(xg @ g1) @ g2
    heads = lambda t: t.astype(F32).reshape(B, L, H, N)
    rh, vh, ah = heads(r), heads(v), heads(a)
    kkh = heads(k * k_k)
    kkh = kkh * lax.rsqrt(jnp.maximum(jnp.sum(kkh * kkh, axis=-1, keepdims=True), 1e-24))
    kh = heads(k) * (1.0 + (ah - 1.0) * k_a.astype(F32).reshape(H, N))
    decay = jnp.exp(-jnp.exp(w_log)).reshape(B, L, H, N)
    def step(S, inp):
        r_t, w_t, k_t, v_t, kk_t, a_t = inp
        sa = jnp.einsum("bhij,bhj->bhi", S, -kk_t)
        S = S * w_t[:, :, None, :] + sa[..., None] * (kk_t * a_t)[:, :, None, :] + v_t[..., None] * k_t[:, :, None, :]
        return S, jnp.einsum("bhij,bhj->bhi", S, r_t)
    seq = lambda t: jnp.moveaxis(t, 1, 0)
    S_new, y = lax.scan(step, S0.astype(F32), (seq(rh), seq(decay), seq(kh), seq(vh), seq(kkh), seq(ah)))
    y = jnp.moveaxis(y, 0, 1)
    mean = jnp.mean(y, axis=-1, keepdims=True)
    var = jnp.mean(jnp.square(y - mean), axis=-1, keepdims=True)
    y = ((y - mean) * lax.rsqrt(var + GN_EPS)).reshape(B, L, D) * lnx_g.astype(F32) + lnx_b.astype(F32)
    y = y + (jnp.sum(rh * kh * r_k.astype(F32), axis=-1, keepdims=True) * vh).reshape(B, L, D)
    out = (y.astype(h.dtype) * g) @ wo
    return out, S_new, h[:, -1], v_layer


def trunk(x, st_hgrn, k_cache, v_cache, st_rwkv, st_shift, pos0, p):
    lbs = hgrn_lower_bounds(p["hgrn_lb_raw"])
    hgrn_out, k_out, v_out, rwkv_out, shift_out = [], [], [], [], []
    v_first = None
    for layer in range(DEPTH):
        h = rmsnorm(x, p["norm_mix_pre"][layer])
        if layer % 2 == 0:
            e = layer // 2
            mix, s_new, k_new, v_new = even_mixer(h, lbs[e], st_hgrn[e], k_cache[e], v_cache[e], pos0,
                                                  p["w_in_even"][e], p["hgrn_norm_g"][e], p["rel_bias"],
                                                  p["attn_sinks"][e], p["w_out_even"][e])
            hgrn_out.append(s_new.astype(st_hgrn.dtype))
            k_out.append(k_new.astype(k_cache.dtype))
            v_out.append(v_new.astype(v_cache.dtype))
        else:
            o = layer // 2
            vres = None if o == 0 else (p["rw_v0"][o - 1], p["rw_v1"][o - 1], p["rw_v2"][o - 1])
            mix, S_new, sh_new, v_layer = rwkv7_mixer(
                h, st_shift[o], st_rwkv[o], v_first, vres, p["rw_mu"][o], p["rw_wr"][o], p["rw_wk"][o],
                p["rw_wv"][o], p["rw_wo"][o], p["rw_w0"][o], p["rw_w1"][o], p["rw_w2"][o], p["rw_a0"][o],
                p["rw_a1"][o], p["rw_a2"][o], p["rw_g1"][o], p["rw_g2"][o], p["rw_kk"][o], p["rw_ka"][o],
                p["rw_rk"][o], p["rw_lnx_g"][o], p["rw_lnx_b"][o])
            if o == 0:
                v_first = v_layer
            rwkv_out.append(S_new.astype(st_rwkv.dtype))
            shift_out.append(sh_new.astype(st_shift.dtype))
        x = x + rmsnorm(mix, p["norm_mix_post"][layer])
        u = rmsnorm(x, p["norm_ffn_pre"][layer])
        u = jnp.square(jax.nn.relu(u @ p["w_up"][layer])) @ p["w_down"][layer]
        x = x + rmsnorm(u, p["norm_ffn_post"][layer])
    return x, jnp.stack(hgrn_out), jnp.stack(k_out), jnp.stack(v_out), jnp.stack(rwkv_out), jnp.stack(shift_out)


def setup_inputs(seed: int = 0) -> dict:
    key = jax.random.key(seed)
    keys = jax.random.split(key, 64)
    counter = [0]
    def nk():
        k = keys[counter[0]]
        counter[0] += 1
        return k
    def nrm(shape, scale=1.0):
        return jax.random.normal(nk(), shape, F32) * scale
    def gain(shape):
        return 1.0 + nrm(shape, 0.05)
    D = D_MODEL
    return {
        "x_prompt": nrm((BATCH, SEQ, D)),
        "x_sample": nrm((DEC_BATCH, DEC_SEQ, D)),
        "state_hgrn": nrm((N_EVEN, DEC_BATCH, A_HEADS, A_KDIM, A_VDIM), 0.5),
        "cache_swa_k": nrm((N_EVEN, DEC_BATCH, WINDOW, B_KV_HEADS, B_HEAD_DIM)),
        "cache_swa_v": nrm((N_EVEN, DEC_BATCH, WINDOW, B_KV_HEADS, B_HEAD_DIM)),
        "state_rwkv": nrm((N_ODD, DEC_BATCH, C_HEADS, C_HEAD, C_HEAD), 0.5),
        "state_shift": nrm((N_ODD, DEC_BATCH, D)),
        "norm_mix_pre": gain((DEPTH, D)),
        "norm_mix_post": gain((DEPTH, D)),
        "norm_ffn_pre": gain((DEPTH, D)),
        "norm_ffn_post": gain((DEPTH, D)),
        "w_in_even": nrm((N_EVEN, D, IN_EVEN), D ** -0.5),
        "w_out_even": nrm((N_EVEN, MIX_WIDTH, D), MIX_WIDTH ** -0.5),
        "hgrn_lb_raw": nrm((N_EVEN, A_QK), 0.5),
        "hgrn_norm_g": gain((N_EVEN, A_WIDTH)),
        "rel_bias": nrm((N_BUCKETS, B_HEADS), 0.5),
        "attn_sinks": nrm((N_EVEN, B_HEADS), 0.5),
        "rw_mu": jax.random.uniform(nk(), (N_ODD, 6, D), F32),
        "rw_wr": nrm((N_ODD, D, D), D ** -0.5),
        "rw_wk": nrm((N_ODD, D, D), D ** -0.5),
        "rw_wv": nrm((N_ODD, D, D), D ** -0.5),
        "rw_wo": nrm((N_ODD, D, D), D ** -0.5),
        "rw_w0": jax.random.uniform(nk(), (N_ODD, D), F32, -6.5, -1.5),
        "rw_w1": nrm((N_ODD, D, LORA_DECAY), D ** -0.5),
        "rw_w2": nrm((N_ODD, LORA_DECAY, D), 0.1 * LORA_DECAY ** -0.5),
        "rw_a0": nrm((N_ODD, D), 0.1),
        "rw_a1": nrm((N_ODD, D, LORA_AAA), D ** -0.5),
        "rw_a2": nrm((N_ODD, LORA_AAA, D), 0.1 * LORA_AAA ** -0.5),
        "rw_v0": nrm((N_ODD - 1, D), 0.1) + 1.0,
        "rw_v1": nrm((N_ODD - 1, D, LORA_MV), D ** -0.5),
        "rw_v2": nrm((N_ODD - 1, LORA_MV, D), 0.1 * LORA_MV ** -0.5),
        "rw_g1": nrm((N_ODD, D, LORA_GATE), D ** -0.5),
        "rw_g2": nrm((N_ODD, LORA_GATE, D), LORA_GATE ** -0.5),
        "rw_kk": 0.85 + nrm((N_ODD, D), 0.05),
        "rw_ka": 1.0 + nrm((N_ODD, D), 0.05),
        "rw_rk": nrm((N_ODD, C_HEADS, C_HEAD), 0.1),
        "rw_lnx_g": gain((N_ODD, D)),
        "rw_lnx_b": nrm((N_ODD, D), 0.02),
        "w_up": nrm((DEPTH, D, D_FF), D ** -0.5),
        "w_down": nrm((DEPTH, D_FF, D), D_FF ** -0.5),
    }


def reference(x_prompt, x_sample, state_hgrn, cache_swa_k, cache_swa_v, state_rwkv, state_shift,
              norm_mix_pre, norm_mix_post, norm_ffn_pre, norm_ffn_post,
              w_in_even, w_out_even, hgrn_lb_raw, hgrn_norm_g, rel_bias, attn_sinks,
              rw_mu, rw_wr, rw_wk, rw_wv, rw_wo, rw_w0, rw_w1, rw_w2, rw_a0, rw_a1, rw_a2,
              rw_v0, rw_v1, rw_v2, rw_g1, rw_g2, rw_kk, rw_ka, rw_rk, rw_lnx_g, rw_lnx_b,
              w_up, w_down):
    p = {
        "norm_mix_pre": norm_mix_pre, "norm_mix_post": norm_mix_post,
        "norm_ffn_pre": norm_ffn_pre, "norm_ffn_post": norm_ffn_post,
        "w_in_even": w_in_even, "w_out_even": w_out_even, "hgrn_lb_raw": hgrn_lb_raw,
        "hgrn_norm_g": hgrn_norm_g, "rel_bias": rel_bias, "attn_sinks": attn_sinks,
        "rw_mu": rw_mu, "rw_wr": rw_wr, "rw_wk": rw_wk, "rw_wv": rw_wv, "rw_wo": rw_wo,
        "rw_w0": rw_w0, "rw_w1": rw_w1, "rw_w2": rw_w2, "rw_a0": rw_a0, "rw_a1": rw_a1, "rw_a2": rw_a2,
        "rw_v0": rw_v0, "rw_v1": rw_v1, "rw_v2": rw_v2, "rw_g1": rw_g1, "rw_g2": rw_g2,
        "rw_kk": rw_kk, "rw_ka": rw_ka, "rw_rk": rw_rk, "rw_lnx_g": rw_lnx_g, "rw_lnx_b": rw_lnx_b,
        "w_up": w_up, "w_down": w_down,
    }
    Bp = x_prompt.shape[0]
    dt = x_prompt.dtype
    zero_hgrn = jnp.zeros((N_EVEN, Bp, A_HEADS, A_KDIM, A_VDIM), dt)
    zero_kv = jnp.zeros((N_EVEN, Bp, 0, B_KV_HEADS, B_HEAD_DIM), dt)
    zero_rwkv = jnp.zeros((N_ODD, Bp, C_HEADS, C_HEAD, C_HEAD), dt)
    zero_shift = jnp.zeros((N_ODD, Bp, D_MODEL), dt)
    y_prompt, hgrn_p, k_p, v_p, rwkv_p, shift_p = trunk(
        x_prompt, zero_hgrn, zero_kv, zero_kv, zero_rwkv, zero_shift, 0, p)
    y_sample, hgrn_s, k_s, v_s, rwkv_s, shift_s = trunk(
        x_sample, state_hgrn, cache_swa_k, cache_swa_v, state_rwkv, state_shift, PAST_LEN, p)
    return (y_prompt, y_sample, hgrn_p, hgrn_s, k_p, k_s, v_p, v_s, rwkv_p, rwkv_s, shift_p, shift_s)
```

```cpp
#include <hip/hip_runtime.h>
#include <hip/hip_cooperative_groups.h>
#include <cstdio>
#include <cstdint>
#include <cmath>
namespace cg = cooperative_groups;

#define LAS __attribute__((address_space(3)))
typedef unsigned short bf16_t;
typedef short bf16x8 __attribute__((ext_vector_type(8)));
typedef float f32x4 __attribute__((ext_vector_type(4)));
typedef unsigned u32x4 __attribute__((ext_vector_type(4)));
typedef unsigned u32x2 __attribute__((ext_vector_type(2)));

constexpr int D = 2048, MP = 8192, MS = 256, M = MP + MS, SEQ = 4096, DSEQ = 8;
constexpr int IN_EVEN = 5632;
constexpr size_t MiB = 1u << 20;
constexpr size_t WS_WB = 0, WS_XA = 104 * MiB, WS_XB = 170 * MiB, WS_HB = 236 * MiB, WS_MIX = 269 * MiB, WS_MA = 335 * MiB, WS_VF = 368 * MiB, WS_T = 434 * MiB;
constexpr size_t WS_PROJ = WS_T, WS_OPART = WS_T + 182 * MiB, WS_HID = WS_T;
constexpr size_t WS_XMIX = WS_T, WS_W2O = WS_T, WS_A2O = WS_T + 66 * MiB, WS_V2O = WS_T + 132 * MiB;
constexpr size_t WS_R = WS_T + 198 * MiB, WS_K = WS_T + 264 * MiB, WS_V3 = WS_T + 330 * MiB, WS_PB = WS_T + 396 * MiB, WS_BAR = WS_PB + 32 * MiB, WS_END = WS_BAR + 1 * MiB;
constexpr int KSPLIT = 16;
constexpr size_t MID_BYTES = (size_t)M * 256 * 2;
constexpr size_t WB_UP = 0, WB_DOWN = 16777216, WB_REST = 33554432;
constexpr size_t WB_WIN = WB_REST, WB_WOUT = WB_REST + 11534336;
constexpr size_t WB_WR = WB_REST, WB_WK = WB_REST + 4194304, WB_WV = WB_REST + 8388608, WB_WO = WB_REST + 12582912, WB_L1 = WB_REST + 16777216, WB_L2 = WB_REST + 18874368;
constexpr size_t OFF_YP = 0, OFF_YS = 16777216, OFF_HP = 17301504, OFF_HS = 17825792, OFF_KP = 26214400, OFF_KS = 26345472, OFF_VP = 28442624, OFF_VS = 28573696,
                 OFF_RP = 30670848, OFF_RS = 31195136, OFF_SP = 39583744, OFF_SS = 39591936;
constexpr int RING_BYTES = 131072, JOBS_OFF = 131072, HDR_OFF = JOBS_OFF + 512, LDS_BYTES = 163840;

struct Params {
    const float* in[40];
    float* out;
    unsigned char* ws;
};


__device__ __forceinline__ const float* IN(int i) {
    int off = i * 8; asm volatile("" : "+s"(off));
    const __attribute__((address_space(4))) char* ka = (const __attribute__((address_space(4))) char*)__builtin_amdgcn_kernarg_segment_ptr();
    return *(const float* const __attribute__((address_space(4)))*)(ka + off);
}
__device__ __forceinline__ float* OUTP() { return (float*)IN(40); }
__device__ __forceinline__ unsigned char* WSP() { return (unsigned char*)IN(41); }


__device__ __forceinline__ int TID() { int t = threadIdx.x; asm volatile("" : "+v"(t)); return t; }
__device__ __forceinline__ int BID() { int b = blockIdx.x; asm volatile("" : "+s"(b)); return b; }
__device__ __forceinline__ int GSZ() { int g = gridDim.x; asm volatile("" : "+s"(g)); return g; }

__device__ __forceinline__ unsigned f2bf(float f) { unsigned u = __builtin_bit_cast(unsigned, f); return (u + 0x7fffu + ((u >> 16) & 1u)) >> 16; }
typedef float f32x2c __attribute__((ext_vector_type(2))); typedef __bf16 bf16x2c __attribute__((ext_vector_type(2)));
__device__ __forceinline__ unsigned pk2(float lo, float hi) { f32x2c v = {lo, hi}; return __builtin_bit_cast(unsigned, __builtin_convertvector(v, bf16x2c)); }
__device__ __forceinline__ float wave_sum(float v) {
#pragma unroll
    for (int o = 1; o < 64; o <<= 1) v += __shfl_xor(v, o);
    return v;
}
template <int CTRL> __device__ __forceinline__ float dppf(float v) {
    return __builtin_bit_cast(float, __builtin_amdgcn_update_dpp(0, __builtin_bit_cast(int, v), CTRL, 0xF, 0xF, true));
}
__device__ __forceinline__ float red16(float v) {
    v += dppf<0xB1>(v); v += dppf<0x4E>(v); v += dppf<0x141>(v); v += dppf<0x140>(v);
    return v;
}
__device__ __forceinline__ float red4(float v) { v += dppf<0xB1>(v); v += dppf<0x4E>(v); return v; }
__device__ __forceinline__ float max4(float v) { v = fmaxf(v, dppf<0xB1>(v)); v = fmaxf(v, dppf<0x4E>(v)); return v; }
__device__ __forceinline__ float sigmoidf_(float x) { return __builtin_amdgcn_rcpf(1.0f + __expf(-x)); }
__device__ __forceinline__ int rfl(int v) { return __builtin_amdgcn_readfirstlane(v); }
__device__ __forceinline__ const char* rfl_ptr(unsigned long long v) {
    unsigned lo = (unsigned)rfl((int)(unsigned)v), hi = (unsigned)rfl((int)(unsigned)(v >> 32));
    return (const char*)(((unsigned long long)hi << 32) | lo);
}


#define XB_TMO      128
#define XB_XCNT(j)  (256  + 64 * (j))
#define XB_XSUB(j)  (1280 + 64 * (j))
#define XB_XGEN(j)  (2304 + 64 * (j))
#define XB_TOP      3328
#define XB_TOPGEN   3392
#define XCD_BAR_WORDS 3456
#define XB_SPIN_CAP (1u << 18)
__device__ __forceinline__ unsigned xb_ld(unsigned* p)              { return __hip_atomic_load(p, __ATOMIC_RELAXED, __HIP_MEMORY_SCOPE_AGENT); }
__device__ __forceinline__ unsigned xb_add(unsigned* p, unsigned v) { return __hip_atomic_fetch_add(p, v, __ATOMIC_RELAXED, __HIP_MEMORY_SCOPE_AGENT); }
__device__ __forceinline__ unsigned xb_xcc_id() { return (unsigned)__builtin_amdgcn_s_getreg((3 << 11) | 20) & 0xFu; }
#define XB_SPIN(cond, bar) do { unsigned _sp = 0; while (cond) { __builtin_amdgcn_s_sleep(1); \
    if ((++_sp & 255u) == 0u) { if (xb_ld(&(bar)[XB_TMO])) break; if (_sp > XB_SPIN_CAP) { atomicAdd(&(bar)[XB_TMO], 1u); break; } } } } while (0)
__device__ __forceinline__ void xcd_barrier_complete(unsigned* bar, unsigned x, unsigned& nloc, unsigned& nx) {
    const unsigned G = gridDim.x * gridDim.y * gridDim.z;
    unsigned sum, cnt, mine, sp = 0u;
    for (;;) {
        sum = 0u; cnt = 0u; mine = 0u;
#pragma unroll
        for (unsigned j = 0; j < 16; ++j) { const unsigned c = xb_ld(&bar[XB_XCNT(j)]); sum += c; cnt += (c > 0u) ? 1u : 0u; mine = (j == x) ? c : mine; }
        if (sum == G) break;
        __builtin_amdgcn_s_sleep(1);
        if ((++sp & 255u) == 0u) { if (xb_ld(&bar[XB_TMO])) break; if (sp > XB_SPIN_CAP) { atomicAdd(&bar[XB_TMO], 1u); break; } }
    }
    nloc = mine > 0u ? mine : 1u; nx = cnt > 0u ? cnt : 1u;
}
__device__ __forceinline__ void xcd_barrier(unsigned* bar, volatile LAS unsigned* st) {
    asm volatile("s_waitcnt vmcnt(0)" ::: "memory");
    __syncthreads();
    if (threadIdx.x == 0) {
        const unsigned x = xb_xcc_id();
        __builtin_amdgcn_s_waitcnt(0);
        unsigned nloc = st[0], nx = st[1];
        if (nloc == 0u) { xcd_barrier_complete(bar, x, nloc, nx); st[0] = nloc; st[1] = nx; }
        const unsigned old = xb_add(&bar[XB_XSUB(x)], 1u);
        const unsigned gen = old / nloc;
        if (old + 1u == (gen + 1u) * nloc) {
            __builtin_amdgcn_fence(__ATOMIC_RELEASE, "agent");
            asm volatile("s_waitcnt vmcnt(0)" ::: "memory");
            const unsigned og = xb_add(&bar[XB_TOP], 1u);
            const unsigned tg = og / nx;
            if (og + 1u == (tg + 1u) * nx) xb_add(&bar[XB_TOPGEN], 1u);
            else XB_SPIN(xb_ld(&bar[XB_TOPGEN]) == tg, bar);
            __builtin_amdgcn_fence(__ATOMIC_ACQUIRE, "agent");
            xb_add(&bar[XB_XGEN(x)], 1u);
            asm volatile("s_waitcnt vmcnt(0)" ::: "memory");
        } else {
            XB_SPIN(xb_ld(&bar[XB_XGEN(x)]) == gen, bar);
            __builtin_amdgcn_fence(__ATOMIC_ACQUIRE, "agent");
            asm volatile("s_waitcnt vmcnt(0)" ::: "memory");
        }
    }
    __syncthreads();
}

namespace pg8 {
constexpr int BM = 256, BK = 64, HALF = 128, HTB = HALF * BK * 2, NXCD = 8, WGM = 8;
__device__ __forceinline__ int lds_byte(int r, int c) { const int st = (r >> 4) * 2 + (c >> 5), rr = r & 15, cc = c & 31, ob = rr * 64 + cc * 2; return st * 1024 + (ob ^ (((ob >> 9) & 1) << 5)); }
__device__ __forceinline__ void stage_rc(int b, int& R, int& C) { const int st = b / 1024, sb = b % 1024, swz = sb ^ (((sb >> 9) & 1) << 5); R = (st >> 1) * 16 + swz / 64; C = (st & 1) * 32 + (swz % 64) / 2; }

struct Job { unsigned long long A, B, C, bias; int nN, ldc, mode, start, ks, pad; };
struct Unit { int pm, pn, j, part, nt; const char* A; const char* B; };

__device__ __forceinline__ bool unit_next(LAS unsigned char* lds, int i, int G, int c, int K, Unit& u) {
    const LAS int* hdr = (const LAS int*)(lds + HDR_OFF);
    const LAS Job* jobs = (const LAS Job*)(lds + JOBS_OFF);
    const int njobs = rfl(hdr[0]), total = rfl(hdr[1]);
    const long L = (long)i * G + c; if (L >= total) return false;
    int l = (int)L, j = 0;
    for (int jj = 1; jj < njobs; ++jj) { if (l >= rfl(jobs[jj].start)) j = jj; }
    l -= rfl(jobs[j].start);
    const int nN = rfl(jobs[j].nN), ks = rfl(jobs[j].ks);
    const int nM = ks > 1 ? (M / BM - 1) : (M / BM), nwg = nM * nN;
    const size_t tstep = (size_t)BM * K * 2;
    const char* A = rfl_ptr(jobs[j].A); const char* B = rfl_ptr(jobs[j].B);
    u.j = j;
    if (l < nwg) {
        int wgid = l; { const int q = nwg / NXCD, r = nwg % NXCD, xcd = wgid % NXCD, off = wgid / NXCD; wgid = (xcd < r ? xcd * (q + 1) : r * (q + 1) + (xcd - r) * q) + off; }
        const int nig = WGM * nN, gid = wgid / nig, fm = gid * WGM, gsz = (nM - fm) < WGM ? (nM - fm) : WGM;
        u.pm = fm + ((wgid % nig) % gsz); u.pn = (wgid % nig) / gsz; u.part = -1; u.nt = K / BK;
        u.A = A + (size_t)u.pm * tstep; u.B = B + (size_t)u.pn * tstep;
    } else {
        const int l2 = l - nwg; u.pm = M / BM - 1; u.pn = l2 / ks; u.part = l2 % ks; u.nt = K / BK / ks;
        const size_t k0 = (size_t)u.part * (K / ks) * 2;
        u.A = A + (size_t)u.pm * tstep + k0; u.B = B + (size_t)u.pn * tstep + k0;
    }
    return true;
}

__device__ __forceinline__ float act_fn(float v, int mode) {
    if (mode == 2) { v = fmaxf(v, 0.f); return v * v; }
    if (mode == 3) { const float e = __expf(2.f * v); return 1.f - 2.f * __builtin_amdgcn_rcpf(e + 1.f); }
    if (mode == 4) return __builtin_amdgcn_rcpf(1.f + __expf(-v));
    return v;
}
__device__ __forceinline__ void epilogue(const f32x4 (&acc)[2][2][4][2], const Unit& u, LAS unsigned char* lds, int wr, int wc, int fr, int fq) {
    const LAS Job* jobs = (const LAS Job*)(lds + JOBS_OFF);
    int ldc = rfl(jobs[u.j].ldc), mode = rfl(jobs[u.j].mode);
    const char* Cp = rfl_ptr(jobs[u.j].C);
    int row0 = u.pm * BM + wr * 64 + fr; const int col0 = u.pn * BM + wc * 32 + 4 * fq;
    if (u.part >= 0) { Cp = (const char*)(WSP() + WS_PB) + (size_t)u.part * 256 * D * 4; row0 = wr * 64 + fr; ldc = D; mode = 0; }
    if (mode == 0 || mode >= 5) {
        float* C = (float*)Cp; const float* bias = (const float*)rfl_ptr(jobs[u.j].bias);
#pragma unroll
        for (int ai = 0; ai < 2; ++ai)
#pragma unroll
            for (int m = 0; m < 4; ++m) { float* rowp = C + (size_t)(row0 + ai * HALF + m * 16) * ldc + col0;
#pragma unroll
                for (int bj = 0; bj < 2; ++bj)
#pragma unroll
                    for (int n = 0; n < 2; ++n) { f32x4 v = acc[ai][bj][m][n];
                        if (mode >= 5) { v += *(const f32x4*)(bias + col0 + bj * HALF + n * 16);
#pragma unroll
                            for (int q = 0; q < 4; ++q) { const float sg = __builtin_amdgcn_rcpf(1.f + __expf(-v[q])); v[q] = mode == 5 ? __expf(-0.6065306597126334f * sg) : sg; } }
                        *(f32x4*)(rowp + bj * HALF + n * 16) = v; }
                asm volatile("" ::: "memory"); }
    } else {
        bf16_t* C = (bf16_t*)Cp;
#pragma unroll
        for (int ai = 0; ai < 2; ++ai)
#pragma unroll
            for (int m = 0; m < 4; ++m) { bf16_t* rowp = C + (size_t)(row0 + ai * HALF + m * 16) * ldc + col0;
#pragma unroll
                for (int bj = 0; bj < 2; ++bj)
#pragma unroll
                    for (int n = 0; n < 2; ++n) { const f32x4 v = acc[ai][bj][m][n]; u32x2 w;
                        w.x = pk2(act_fn(v[0], mode), act_fn(v[1], mode)); w.y = pk2(act_fn(v[2], mode), act_fn(v[3], mode));
                        *(u32x2*)(rowp + bj * HALF + n * 16) = w; } }
    }
}

__device__ __forceinline__ void gemm_phase(LAS unsigned char* lds, const int K, const int G, const int c) {
    const int tid = TID(), wid = rfl(tid >> 6), lane = tid & 63, wr = wid >> 2, wc = wid & 3, fr = lane & 15, fq = lane >> 4;
    unsigned voff[2];
#pragma unroll
    for (int i = 0; i < 2; ++i) { int R, C; stage_rc(tid * 16 + i * 8192, R, C); voff[i] = (unsigned)(R * K + C) * 2u; }
    const size_t kstep = (size_t)(BK * 2);
    const size_t hstep = (size_t)HALF * K * 2;
    const unsigned ldsw = (unsigned)wid * 1024u;
    const int aoff = lds_byte(wr * 64 + fr, fq * 8), boff = lds_byte(wc * 32 + fr, fq * 8);
#define PG8_SA(b, h) (((b) * 2 + (h)) * HTB)
#define PG8_SB(b, h) ((4 + (b) * 2 + (h)) * HTB)
#define PG8_STAGE(bufoff, gbase) do { _Pragma("unroll") for (int _i = 0; _i < 2; ++_i) \
        __builtin_amdgcn_global_load_lds((const unsigned*)((const char*)(gbase) + voff[_i]), (LAS unsigned*)(lds + (bufoff) + ldsw + _i * 8192), 16, 0, 0); } while (0)
#define PG8_LDA(dst, b, h) do { _Pragma("unroll") for (int m = 0; m < 4; ++m) _Pragma("unroll") for (int k = 0; k < 2; ++k) dst[m][k] = *(const LAS bf16x8*)(lds + PG8_SA(b, h) + aoff + m * 2048 + k * 1024); } while (0)
#define PG8_LDB(dst, b, h) do { _Pragma("unroll") for (int n = 0; n < 2; ++n) _Pragma("unroll") for (int k = 0; k < 2; ++k) dst[n][k] = *(const LAS bf16x8*)(lds + PG8_SB(b, h) + boff + n * 2048 + k * 1024); } while (0)
#define PG8_MMA(ai, bj, At, Bt) do { __builtin_amdgcn_s_setprio(1); _Pragma("unroll") for (int m = 0; m < 4; ++m) _Pragma("unroll") for (int n = 0; n < 2; ++n) _Pragma("unroll") for (int k = 0; k < 2; ++k) \
        acc[ai][bj][m][n] = __builtin_amdgcn_mfma_f32_16x16x32_bf16(Bt[n][k], At[m][k], acc[ai][bj][m][n], 0, 0, 0); __builtin_amdgcn_s_setprio(0); } while (0)
#define PG8_WAIT_V(n) asm volatile("s_waitcnt vmcnt(" #n ")" ::: "memory")
#define PG8_WAIT_L(n) asm volatile("s_waitcnt lgkmcnt(" #n ")" ::: "memory")
#define PG8_BAR __builtin_amdgcn_s_barrier()
#define PG8_SCHED __builtin_amdgcn_sched_barrier(0)
    Unit cur, nxt; int ui = 0;
    if (!unit_next(lds, 0, G, c, K, cur)) return;
    f32x4 acc[2][2][4][2];
#pragma unroll
    for (int a = 0; a < 2; ++a)
#pragma unroll
        for (int b = 0; b < 2; ++b)
#pragma unroll
            for (int m = 0; m < 4; ++m)
#pragma unroll
                for (int n = 0; n < 2; ++n) acc[a][b][m][n] = (f32x4){0.f, 0.f, 0.f, 0.f};
    bf16x8 At[4][2], B0[2][2], B1[2][2];
    const char* cA = cur.A; const char* cB = cur.B;
    PG8_STAGE(PG8_SB(0, 0), cB); PG8_STAGE(PG8_SB(0, 1), cB + hstep); PG8_STAGE(PG8_SA(0, 0), cA); PG8_STAGE(PG8_SA(0, 1), cA + hstep);
    if (wr == 1) PG8_BAR;
    PG8_WAIT_V(2); PG8_BAR;
    PG8_STAGE(PG8_SB(1, 0), cB + kstep); PG8_STAGE(PG8_SA(1, 0), cA + kstep); PG8_STAGE(PG8_SB(1, 1), cB + hstep + kstep);
    PG8_WAIT_V(6); PG8_BAR;
    for (;;) {
        const bool has_next = unit_next(lds, ui + 1, G, c, K, nxt);
        const char* nA = has_next ? nxt.A : cA; const char* nB = has_next ? nxt.B : cB;
        const int nt = cur.nt;
        for (int t = 0; t < nt; t += 2) {
            const bool last = (t == nt - 2);
            const char* a1 = cA + (size_t)(t + 1) * kstep;
            const char* a2 = last ? nA : cA + (size_t)(t + 2) * kstep; const char* b2 = last ? nB : cB + (size_t)(t + 2) * kstep;
            const char* a3 = a2 + kstep; const char* b3 = b2 + kstep;
            PG8_LDB(B0, 0, 0); PG8_LDB(B1, 0, 1); PG8_SCHED; PG8_LDA(At, 0, 0); PG8_STAGE(PG8_SA(1, 1), a1 + hstep);
            PG8_WAIT_V(8); PG8_WAIT_L(0); PG8_BAR; PG8_MMA(0, 0, At, B0); PG8_MMA(0, 1, At, B1); PG8_BAR; PG8_SCHED;
            PG8_LDA(At, 0, 1); PG8_STAGE(PG8_SB(0, 0), b2); PG8_STAGE(PG8_SB(0, 1), b2 + hstep); PG8_STAGE(PG8_SA(0, 0), a2);
            PG8_WAIT_V(8); PG8_WAIT_L(0); PG8_BAR; PG8_MMA(1, 0, At, B0); PG8_MMA(1, 1, At, B1); PG8_BAR; PG8_SCHED;
            PG8_LDB(B0, 1, 0); PG8_LDB(B1, 1, 1); PG8_SCHED; PG8_LDA(At, 1, 0); PG8_STAGE(PG8_SA(0, 1), a2 + hstep);
            PG8_WAIT_V(8); PG8_WAIT_L(0); PG8_BAR; PG8_MMA(0, 0, At, B0); PG8_MMA(0, 1, At, B1); PG8_BAR; PG8_SCHED;
            PG8_LDA(At, 1, 1); PG8_STAGE(PG8_SB(1, 0), b3); PG8_STAGE(PG8_SB(1, 1), b3 + hstep); PG8_STAGE(PG8_SA(1, 0), a3);
            PG8_WAIT_V(8); PG8_WAIT_L(0); PG8_BAR; PG8_MMA(1, 0, At, B0); PG8_MMA(1, 1, At, B1); PG8_BAR; PG8_SCHED;
        }
        if (wr == 0) PG8_BAR;
        epilogue(acc, cur, lds, wr, wc, fr, fq);
        if (!has_next) break;
#pragma unroll
        for (int a = 0; a < 2; ++a)
#pragma unroll
            for (int b = 0; b < 2; ++b)
#pragma unroll
                for (int m = 0; m < 4; ++m)
#pragma unroll
                    for (int n = 0; n < 2; ++n) acc[a][b][m][n] = (f32x4){0.f, 0.f, 0.f, 0.f};
        cur = nxt; cA = nA; cB = nB; ++ui;
        if (wr == 1) PG8_BAR;
    }
    PG8_WAIT_V(0);
    PG8_BAR;
#undef PG8_SA
#undef PG8_SB
#undef PG8_STAGE
#undef PG8_LDA
#undef PG8_LDB
#undef PG8_MMA
#undef PG8_WAIT_V
#undef PG8_WAIT_L
#undef PG8_BAR
#undef PG8_SCHED
}
}

__device__ __forceinline__ void conv_mat(const float* W, int K, int N, bf16_t* WT, int Kp, int Np, LAS float* scr, int gw, int ngw, int lane) {
    const int nblk = Np / 32, nitems = nblk * (Kp / 64);
    f32x4 nv[8];
#define CONV_LOAD(it_) do { const int kb_ = (it_) / nblk, nb_ = (it_) % nblk; _Pragma("unroll") for (int i = 0; i < 8; ++i) { const int k_ = 64 * kb_ + 8 * i + (lane >> 3), n_ = 32 * nb_ + (lane & 7) * 4; \
        nv[i] = (k_ < K && 32 * nb_ < N) ? *(const f32x4*)(W + (size_t)k_ * N + n_) : (f32x4){0.f, 0.f, 0.f, 0.f}; } } while (0)
    if (gw < nitems) CONV_LOAD(gw);
    for (int item = gw; item < nitems; item += ngw) {
        const int kb = item / nblk, nb = item % nblk, k0 = 64 * kb, n0 = 32 * nb;
#pragma unroll
        for (int i = 0; i < 8; ++i) { const int kk = 8 * i + (lane >> 3), n4 = (lane & 7) * 4; LAS float* d = scr + kk * 33 + n4; d[0] = nv[i][0]; d[1] = nv[i][1]; d[2] = nv[i][2]; d[3] = nv[i][3]; }
        if (item + ngw < nitems) CONV_LOAD(item + ngw);
        asm volatile("s_waitcnt lgkmcnt(0)" ::: "memory");
        const int c = lane & 7;
#pragma unroll
        for (int j = 0; j < 4; ++j) { const int n = (lane >> 3) + 8 * j; const LAS float* s = scr + (8 * c) * 33 + n;
            u32x4 o; o.x = pk2(s[0 * 33], s[1 * 33]); o.y = pk2(s[2 * 33], s[3 * 33]); o.z = pk2(s[4 * 33], s[5 * 33]); o.w = pk2(s[6 * 33], s[7 * 33]);
            *(u32x4*)(WT + (size_t)(n0 + n) * Kp + k0 + 8 * c) = o; }
        asm volatile("s_waitcnt lgkmcnt(0)" ::: "memory");
    }
#undef CONV_LOAD
}

__device__ __forceinline__ void row_load(const float* p, int lane, f32x4 (&v)[8]) {
#pragma unroll
    for (int j = 0; j < 8; ++j) v[j] = *(const f32x4*)(p + 256 * j + 4 * lane);
}
__device__ __forceinline__ void row_load_bf16(const bf16_t* p, int lane, f32x4 (&v)[8]) {
#pragma unroll
    for (int j = 0; j < 8; ++j) { const u32x2 r = *(const u32x2*)(p + 256 * j + 4 * lane);
        v[j][0] = __builtin_bit_cast(float, r.x << 16); v[j][1] = __builtin_bit_cast(float, r.x & 0xffff0000u); v[j][2] = __builtin_bit_cast(float, r.y << 16); v[j][3] = __builtin_bit_cast(float, r.y & 0xffff0000u); }
}
__device__ __forceinline__ float row_rstd(const f32x4 (&v)[8]) {
    float s = 0.f;
#pragma unroll
    for (int j = 0; j < 8; ++j) s += (v[j][0] * v[j][0] + v[j][1] * v[j][1]) + (v[j][2] * v[j][2] + v[j][3] * v[j][3]);
    return rsqrtf(wave_sum(s) * (1.f / D) + 1e-6f);
}
__device__ __forceinline__ void row_store_bf16(bf16_t* p, int lane, const f32x4 (&v)[8]) {
#pragma unroll
    for (int j = 0; j < 8; ++j) { u32x2 w; w.x = pk2(v[j][0], v[j][1]); w.y = pk2(v[j][2], v[j][3]); *(u32x2*)(p + 256 * j + 4 * lane) = w; }
}
__device__ __forceinline__ void presum_sample_rows(bf16_t* MIX, int bid, int tid) {
    if (bid < MS / 4) {
#pragma unroll 1
        for (int r = 0; r < 4; ++r) {
            const size_t off = (size_t)(4 * bid + r) * D + 4 * tid;
            const float* pb = (const float*)(WSP() + WS_PB) + off;
            f32x4 v[KSPLIT];
#pragma unroll
            for (int k = 0; k < KSPLIT; ++k) v[k] = *(const f32x4*)(pb + (size_t)k * 256 * D);
#pragma unroll
            for (int k = 1; k < KSPLIT; ++k) v[0] += v[k];
            { u32x2 w; w.x = pk2(v[0][0], v[0][1]); w.y = pk2(v[0][2], v[0][3]); *(u32x2*)(MIX + (size_t)MP * D + off) = w; }
        }
    }
    __syncthreads();
}
__device__ __forceinline__ void xrow_load(const bf16_t* X, int layer0, int m, int lane, f32x4 (&v)[8]) {
    if (layer0) row_load(m < MP ? IN(0) + (size_t)m * D : IN(1) + (size_t)(m - MP) * D, lane, v);
    else row_load_bf16(X + (size_t)m * D, lane, v);
}

__device__ __forceinline__ void row_pre(const Params& p, int layer) {
    const int tid_ = TID(), lane = tid_ & 63, wave_ = rfl(tid_ >> 6), bid_ = BID(), gw = bid_ * 8 + wave_, ngw = GSZ() * 8;
    unsigned char* ws = WSP();
    const bf16_t* Xold = (const bf16_t*)(ws + ((layer & 1) ? WS_XA : WS_XB));
    bf16_t* Xnew = (bf16_t*)(ws + ((layer & 1) ? WS_XB : WS_XA));
    const bf16_t* DOWN = (const bf16_t*)(ws + WS_MIX);
    if (layer > 0) presum_sample_rows((bf16_t*)(ws + WS_MIX), bid_, tid_);
    const float* gpost = IN(10) + (size_t)(layer - 1) * D;
    const float* gpre = IN(7) + (size_t)layer * D;
    const bool odd = layer & 1;
    const int o = layer >> 1;
    const int nit = (MP / 4 - gw + ngw - 1) / ngw;
    for (int it_ = 0; it_ <= nit; ++it_) {
        int item = gw + it_ * ngw;
        if (it_ == nit) { if (wave_ != 0 || bid_ >= MS / 4) break; item = MP / 4 + bid_; }
        const int m0 = item * 4;
        const int t0 = m0 < MP ? (m0 & (SEQ - 1)) : ((m0 - MP) & (DSEQ - 1));
        const int b = m0 < MP ? (m0 >> 12) : ((m0 - MP) >> 3);
        const int Lseq = m0 < MP ? SEQ : DSEQ;
        f32x4 hp[8];
        const int rstart = (odd && t0 > 0) ? -1 : 0;
        if (odd && t0 == 0) {
            if (m0 < MP) {
#pragma unroll
                for (int j = 0; j < 8; ++j) hp[j] = (f32x4){0.f, 0.f, 0.f, 0.f};
            } else row_load(IN(6) + ((size_t)o * 32 + b) * D, lane, hp);
        }
        for (int r = rstart; r < 4; ++r) {
            const int m = m0 + r;
            f32x4 x[8];
            xrow_load(Xold, layer == 0, m, lane, x);
            if (layer > 0) {
                f32x4 dn[8]; row_load_bf16(DOWN + (size_t)m * D, lane, dn);
                const float rs = row_rstd(dn);
#pragma unroll
                for (int j = 0; j < 8; ++j) { const f32x4 g = *(const f32x4*)(gpost + 256 * j + 4 * lane); x[j] += dn[j] * rs * g; }
                if (r >= 0) {
#pragma unroll
                    for (int j = 0; j < 8; ++j) { if (layer == 4) *(f32x4*)(OUTP() + (size_t)m * D + 256 * j + 4 * lane) = x[j];
                        else { u32x2 w; w.x = pk2(x[j][0], x[j][1]); w.y = pk2(x[j][2], x[j][3]); *(u32x2*)(Xnew + (size_t)m * D + 256 * j + 4 * lane) = w; } }
                }
            }
            if (layer == 4) continue;
            const float rs = row_rstd(x);
#pragma unroll
            for (int j = 0; j < 8; ++j) { const f32x4 g = *(const f32x4*)(gpre + 256 * j + 4 * lane); x[j] = x[j] * rs * g; }
            if (!odd) { row_store_bf16((bf16_t*)(ws + WS_HB) + (size_t)m * D, lane, x); continue; }
            if (r >= 0) {
                const float* mu = IN(17) + (size_t)o * 6 * D;
#pragma unroll 1
                for (int i = 0; i < 6; ++i) {
                    bf16_t* dst = (bf16_t*)(ws + WS_XMIX) + (size_t)i * M * D + (size_t)m * D;
#pragma unroll
                    for (int j = 0; j < 8; ++j) { const f32x4 mv = *(const f32x4*)(mu + (size_t)i * D + 256 * j + 4 * lane); const f32x4 y = x[j] + (hp[j] - x[j]) * mv;
                        u32x2 w; w.x = pk2(y[0], y[1]); w.y = pk2(y[2], y[3]); *(u32x2*)(dst + 256 * j + 4 * lane) = w; }
                }
                if (t0 + r == Lseq - 1) {
                    float* so = OUTP() + (m0 < MP ? OFF_SP + ((size_t)o * 2 + b) * D : OFF_SS + ((size_t)o * 32 + b) * D);
#pragma unroll
                    for (int j = 0; j < 8; ++j) *(f32x4*)(so + 256 * j + 4 * lane) = x[j];
                }
            }
#pragma unroll
            for (int j = 0; j < 8; ++j) hp[j] = x[j];
        }
    }
}

__device__ __forceinline__ void row_post1(const Params& p, int layer) {
    const int tid_ = TID(), lane = tid_ & 63, wave_ = rfl(tid_ >> 6), bid_ = BID(), gw = bid_ * 8 + wave_, ngw = GSZ() * 8;
    unsigned char* ws = WSP();
    bf16_t* X = (bf16_t*)(ws + ((layer & 1) ? WS_XB : WS_XA));
    const bf16_t* MIX = (const bf16_t*)(ws + WS_MIX);
    const float* g1 = IN(8) + (size_t)layer * D; const float* g2 = IN(9) + (size_t)layer * D;
    presum_sample_rows((bf16_t*)(ws + WS_MIX), bid_, tid_);
    const int nit = (MP - gw + ngw - 1) / ngw;
    for (int it_ = 0; it_ <= nit; ++it_) {
        int m = gw + it_ * ngw;
        if (it_ == nit) { if (wave_ >= 4 || bid_ >= MS / 4) break; m = MP + 4 * bid_ + wave_; }
        f32x4 x[8], mx[8];
        xrow_load(X, layer == 0, m, lane, x);
        row_load_bf16(MIX + (size_t)m * D, lane, mx);
        const float rs = row_rstd(mx);
#pragma unroll
        for (int j = 0; j < 8; ++j) { const f32x4 g = *(const f32x4*)(g1 + 256 * j + 4 * lane); x[j] += mx[j] * rs * g; u32x2 w; w.x = pk2(x[j][0], x[j][1]); w.y = pk2(x[j][2], x[j][3]); *(u32x2*)(X + (size_t)m * D + 256 * j + 4 * lane) = w; }
        const float rs2 = row_rstd(x);
#pragma unroll
        for (int j = 0; j < 8; ++j) { const f32x4 g = *(const f32x4*)(g2 + 256 * j + 4 * lane); x[j] = x[j] * rs2 * g; }
        row_store_bf16((bf16_t*)(ws + WS_HB) + (size_t)m * D, lane, x);
    }
}

__device__ __forceinline__ void row_hg(const Params& p, int e) {
    const int tid_ = TID(), lane = tid_ & 63, gw = BID() * 8 + rfl(tid_ >> 6), ngw = GSZ() * 8;
    unsigned char* ws = WSP();
    const float* O0 = (const float*)(ws + WS_OPART); const float* O1 = O0 + (size_t)M * 1024;
    const float* PROJ = (const float*)(ws + WS_PROJ);
    const float* g = IN(14) + (size_t)e * 1024;
    bf16_t* MA = (bf16_t*)(ws + WS_MA);
    for (int m = gw; m < M; m += ngw) {
        f32x4 v[4]; float s = 0.f;
#pragma unroll
        for (int j = 0; j < 4; ++j) { v[j] = *(const f32x4*)(O0 + (size_t)m * 1024 + 256 * j + 4 * lane); if (m >= MP) v[j] += *(const f32x4*)(O1 + (size_t)m * 1024 + 256 * j + 4 * lane);
            s += (v[j][0] * v[j][0] + v[j][1] * v[j][1]) + (v[j][2] * v[j][2] + v[j][3] * v[j][3]); }
        const float rs = rsqrtf(wave_sum(s) * (1.f / 1024.f) + 1e-6f);
#pragma unroll
        for (int j = 0; j < 4; ++j) { const f32x4 gg = *(const f32x4*)(g + 256 * j + 4 * lane); const f32x4 ga = *(const f32x4*)(PROJ + (size_t)m * IN_EVEN + 3072 + 256 * j + 4 * lane);
            f32x4 y = v[j] * rs * gg;
#pragma unroll
            for (int q = 0; q < 4; ++q) y[q] *= ga[q] * sigmoidf_(ga[q]);
            u32x2 w; w.x = pk2(y[0], y[1]); w.y = pk2(y[2], y[3]); *(u32x2*)(MA + (size_t)m * D + 256 * j + 4 * lane) = w; }
    }
}

__device__ __forceinline__ void row_gn(const Params& p, int layer) {
    const int tid_ = TID(), lane = tid_ & 63, gw = BID() * 8 + rfl(tid_ >> 6), ngw = GSZ() * 8;
    unsigned char* ws = WSP(); const int o = layer >> 1;
    const float* Y = (const float*)(ws + WS_MIX);
    const float* BONUS = (const float*)(ws + WS_XA);
    const bf16_t* G2O = (const bf16_t*)(ws + WS_HB);
    const float* lg = IN(36) + (size_t)o * D; const float* lb = IN(37) + (size_t)o * D;
    bf16_t* MA = (bf16_t*)(ws + WS_MA);
    for (int m = gw; m < M; m += ngw) {
#pragma unroll
        for (int j = 0; j < 8; ++j) {
            const int c = 256 * j + 4 * lane;
            const f32x4 y = *(const f32x4*)(Y + (size_t)m * D + c);
            const float mean = red16((y[0] + y[1]) + (y[2] + y[3])) * (1.f / 64.f);
            const f32x4 d = y - mean;
            const float var = red16((d[0] * d[0] + d[1] * d[1]) + (d[2] * d[2] + d[3] * d[3])) * (1.f / 64.f);
            const float rs = rsqrtf(var + 64e-5f);
            const f32x4 bo = *(const f32x4*)(BONUS + (size_t)m * D + c);
            const u32x2 gr = *(const u32x2*)(G2O + (size_t)m * D + c);
            const f32x4 gg = *(const f32x4*)(lg + c), bb = *(const f32x4*)(lb + c);
            f32x4 gt; gt[0] = __builtin_bit_cast(float, gr.x << 16); gt[1] = __builtin_bit_cast(float, gr.x & 0xffff0000u); gt[2] = __builtin_bit_cast(float, gr.y << 16); gt[3] = __builtin_bit_cast(float, gr.y & 0xffff0000u);
            const f32x4 r = (d * rs * gg + bb + bo) * gt;
            u32x2 w; w.x = pk2(r[0], r[1]); w.y = pk2(r[2], r[3]); *(u32x2*)(MA + (size_t)m * D + c) = w;
        }
    }
}

constexpr int REC = 336, CH = 32;
constexpr int YP_OFF = 2 * CH * REC;
constexpr int NITEMS_SCAN = 256 + 4096;
typedef float f32x2 __attribute__((ext_vector_type(2)));
struct ScanDesc { int b, h, kh, row0, tok0, nv, samp, ok; };
template <bool RW> __device__ __forceinline__ ScanDesc scan_desc(int it, int c) {
    ScanDesc d; d.ok = it < NITEMS_SCAN; d.samp = it >= 256; const int ii = d.samp ? it - 256 : it; d.kh = 0;
    if (RW) { const int chain = ii >> 2; d.row0 = (ii & 3) * 16; d.b = chain >> 5; d.h = chain & 31; }
    else { const int chain = ii >> 3; d.row0 = (ii & 7) * 16; d.b = chain >> 4; d.h = (chain >> 1) & 7; d.kh = chain & 1; }
    const int L = d.samp ? DSEQ : SEQ; d.tok0 = (d.samp ? MP + d.b * DSEQ : d.b * SEQ) + c * CH; d.nv = (L - c * CH) < CH ? (L - c * CH) : CH;
    return d;
}
__device__ __forceinline__ void scan_adv(int& it, int& c, int gsz) { ++c; if (c >= (it < 256 ? SEQ / CH : 1)) { c = 0; it += gsz; } }
struct ScanRec { f32x4 w, k, r, kk, kka; float v; };
#define LO2(x) __builtin_shufflevector(x, x, 0, 1)
#define HI2(x) __builtin_shufflevector(x, x, 2, 3)

template <bool RW>
__device__ __forceinline__ void scan_phase(const Params& p, LAS unsigned char* lds8, const int li  , const int it0 = 0) {
    unsigned char* ws = WSP();
    LAS float* lds = (LAS float*)lds8;
    const int tid = TID(), wave = rfl(tid >> 6), lane = tid & 63, bid = BID(), gsz = GSZ();
    const bool consumer = wave < 4;
    const float* R_ = (const float*)(ws + WS_R); const float* K_ = (const float*)(ws + WS_K);
    const float* V_ = (const float*)(ws + (li == 0 ? WS_VF : WS_V3)); const float* VF_ = (const float*)(ws + WS_VF);
    const float* W2O = (const float*)(ws + WS_W2O); const float* A2O = (const float*)(ws + WS_A2O); const float* V2O = (const float*)(ws + WS_V2O);
    float* Y_ = (float*)(ws + WS_MIX); float* BONUS = (float*)(ws + WS_XA);
    const float* PROJ = (const float*)(ws + WS_PROJ); float* OPART = (float*)(ws + WS_OPART);
    const int ptid = tid & 255, tt = ptid >> 4, c4 = ptid & 15;
    f32x4 raw[2][7], cp[6];
    ScanDesc pd; pd.ok = 0;
    int lit = it0 + bid, lc = 0;
    const int rg = lane >> 4, cl = lane & 15, crow = (wave & 3) * 4 + rg;
    f32x2 s01 = (f32x2){0.f, 0.f}, s23 = s01; f32x4 snext = (f32x4){0.f, 0.f, 0.f, 0.f};
#define P_LOAD() do { pd = scan_desc<RW>(lit, lc); if (pd.ok) { \
        if (RW) { const int c_ = pd.h * 64 + 4 * c4; \
            cp[3] = *(const f32x4*)(IN(33) + (size_t)li * D + c_); cp[4] = *(const f32x4*)(IN(34) + (size_t)li * D + c_); cp[5] = *(const f32x4*)(IN(35) + (size_t)li * D + c_); \
        } else if (li) { const int c_ = pd.h * 128 + pd.kh * 64 + 4 * c4; cp[0] = *(const f32x4*)(IN(13) + c_); cp[1] = *(const f32x4*)(IN(13) + 1024 + c_); } \
        _Pragma("unroll") for (int pr = 0; pr < 2; ++pr) { const int tl_ = tt + 16 * pr; if (tl_ < pd.nv) { const size_t m_ = (size_t)(pd.tok0 + tl_); \
            if (RW) { const size_t o_ = m_ * D + pd.h * 64 + 4 * c4; raw[pr][0] = *(const f32x4*)(R_ + o_); raw[pr][1] = *(const f32x4*)(K_ + o_); raw[pr][2] = *(const f32x4*)(V_ + o_); \
                raw[pr][3] = *(const f32x4*)(W2O + o_); raw[pr][4] = *(const f32x4*)(A2O + o_); if (li) { raw[pr][5] = *(const f32x4*)(V2O + o_); raw[pr][6] = *(const f32x4*)(VF_ + o_); } } \
            else { const size_t o_ = m_ * IN_EVEN + pd.h * 128 + pd.kh * 64 + 4 * c4; raw[pr][0] = *(const f32x4*)(PROJ + o_); raw[pr][1] = *(const f32x4*)(PROJ + 1024 + o_); \
                if (c4 < 4) raw[pr][2] = *(const f32x4*)(PROJ + m_ * IN_EVEN + 2048 + pd.h * 128 + pd.row0 + 4 * c4); } } } } \
        scan_adv(lit, lc, gsz); } while (0)
#define P_PUT(buf) do { if (pd.ok) { _Pragma("unroll") for (int pr = 0; pr < 2; ++pr) { const int tl_ = tt + 16 * pr; if (tl_ < pd.nv) { LAS float* rec_ = (buf) + tl_ * REC + 4 * c4; \
        if (RW) { f32x4 dec, a, v = raw[pr][2], kk, km, kka; float ss = 0.f, rk = 0.f; \
            _Pragma("unroll") for (int q_ = 0; q_ < 4; ++q_) { dec[q_] = raw[pr][3][q_]; \
                a[q_] = raw[pr][4][q_]; if (li) v[q_] = raw[pr][2][q_] + (raw[pr][6][q_] - raw[pr][2][q_]) * raw[pr][5][q_]; \
                kk[q_] = raw[pr][1][q_] * cp[3][q_]; ss += kk[q_] * kk[q_]; km[q_] = raw[pr][1][q_] * (1.f + (a[q_] - 1.f) * cp[4][q_]); rk += raw[pr][0][q_] * km[q_] * cp[5][q_]; } \
            ss = red16(ss); rk = red16(rk); const float inv = rsqrtf(fmaxf(ss, 1e-24f)); \
            _Pragma("unroll") for (int q_ = 0; q_ < 4; ++q_) { kk[q_] *= inv; kka[q_] = kk[q_] * a[q_]; } \
            *(LAS f32x4*)(rec_) = dec; *(LAS f32x4*)(rec_ + 64) = km; *(LAS f32x4*)(rec_ + 128) = raw[pr][0]; *(LAS f32x4*)(rec_ + 192) = kk; *(LAS f32x4*)(rec_ + 256) = kka; \
            if ((c4 >> 2) == (pd.row0 >> 4)) { *(LAS f32x4*)((buf) + tl_ * REC + 320 + 4 * (c4 & 3)) = v; *(f32x4*)(BONUS + (size_t)(pd.tok0 + tl_) * D + pd.h * 64 + 4 * c4) = v * rk; } } \
        else { f32x4 f, kk, qq; \
            _Pragma("unroll") for (int q_ = 0; q_ < 4; ++q_) { const float plb = li ? sigmoidf_(cp[1][q_] - cp[0][q_]) : 0.f; \
                const float sg = sigmoidf_(raw[pr][1][q_]); f[q_] = plb + (1.f - plb) * sg; kk[q_] = (1.f - plb) * (1.f - sg); qq[q_] = raw[pr][0][q_] * sigmoidf_(raw[pr][0][q_]) * 0.08838834764831845f; } \
            *(LAS f32x4*)(rec_) = f; *(LAS f32x4*)(rec_ + 64) = kk; *(LAS f32x4*)(rec_ + 128) = qq; \
            if (c4 < 4) *(LAS f32x4*)((buf) + tl_ * REC + 320 + 4 * c4) = raw[pr][2]; } } } } } while (0)
#define P_REDUCE(yd, par) do { const LAS float* yp_ = lds + YP_OFF + (par) * (CH * 256); \
        _Pragma("unroll") for (int k_ = 0; k_ < 2; ++k_) { const int idx = ptid + 256 * k_, t_ = idx >> 4, row = idx & 15; \
            if (t_ < (yd).nv) { const LAS f32x4* s4 = (const LAS f32x4*)(yp_ + idx * 16); const f32x4 a_ = (s4[0] + s4[1]) + (s4[2] + s4[3]); const float y_ = (a_[0] + a_[1]) + (a_[2] + a_[3]); \
                if (RW) Y_[(size_t)((yd).tok0 + t_) * D + (yd).h * 64 + (yd).row0 + row] = y_; \
                else OPART[(size_t)(yd).kh * M * 1024 + (size_t)((yd).tok0 + t_) * 1024 + (yd).h * 128 + (yd).row0 + row] = y_; } } } while (0)
#define C_S0(dd, dst) do { if (RW) dst = *(const f32x4*)(IN(5) + ((((size_t)li * 32 + (dd).b) * 32 + (dd).h) * 64 + (dd).row0 + crow) * 64 + 4 * cl); \
        else { const float* S0_ = IN(2) + (((size_t)li * 32 + (dd).b) * 8 + (dd).h) * 16384 + (size_t)((dd).kh * 64 + 4 * cl) * 128 + (dd).row0 + crow; \
            dst[0] = S0_[0]; dst[1] = S0_[128]; dst[2] = S0_[256]; dst[3] = S0_[384]; } } while (0)
    __syncthreads();
    int cit = it0 + bid, cc = 0;
    if (!consumer) { P_LOAD(); P_PUT(lds); P_LOAD(); }
    else { const ScanDesc d0 = scan_desc<RW>(cit, cc); if (d0.ok && d0.samp) C_S0(d0, snext); }
    __syncthreads();
    ScanDesc prevd; prevd.ok = 0; prevd.nv = 0; prevd.tok0 = 0; prevd.h = 0; prevd.kh = 0; prevd.row0 = 0;
    int q = 0;
    for (;; ++q) {
        const ScanDesc cd = scan_desc<RW>(cit, cc);
        if (!cd.ok) break;
        if (consumer) {
            int nit = cit, nc = cc; scan_adv(nit, nc, gsz); const ScanDesc nd = scan_desc<RW>(nit, nc);
            if (cc == 0) { if (cd.samp) { s01 = LO2(snext); s23 = HI2(snext); } else { s01 = (f32x2){0.f, 0.f}; s23 = s01; } }
            if (nd.ok && nc == 0 && nd.samp) C_S0(nd, snext);
            const LAS float* cur = lds + (q & 1) * (CH * REC);
            LAS float* yp = lds + YP_OFF + (q & 1) * (CH * 256) + crow * 16 + cl;
#define C_LD(R, t) do { const LAS float* rec_ = cur + (t) * REC; R.w = *(const LAS f32x4*)(rec_ + 4 * cl); R.k = *(const LAS f32x4*)(rec_ + 64 + 4 * cl); R.r = *(const LAS f32x4*)(rec_ + 128 + 4 * cl); \
                if (RW) { R.kk = *(const LAS f32x4*)(rec_ + 192 + 4 * cl); R.kka = *(const LAS f32x4*)(rec_ + 256 + 4 * cl); } R.v = rec_[320 + crow]; } while (0)
#define SB_ __builtin_amdgcn_sched_barrier(0)
#define C_STEP(R, t) do { \
                if (RW) { f32x2 pp = s01 * LO2(R.kk); pp = s23 * HI2(R.kk) + pp; float x_ = pp.x + pp.y; SB_; \
                      \
                    x_ += dppf<0xB1>(x_); SB_; f32x2 t01 = s01 * LO2(R.w); SB_; \
                    x_ += dppf<0x4E>(x_); SB_; f32x2 t23 = s23 * HI2(R.w); SB_; \
                    x_ += dppf<0x141>(x_); SB_; t01 = LO2(R.k) * R.v + t01; SB_; \
                    x_ += dppf<0x140>(x_); SB_; t23 = HI2(R.k) * R.v + t23; SB_; \
                    const float sa = -x_; s01 = LO2(R.kka) * sa + t01; s23 = HI2(R.kka) * sa + t23; } \
                else { s01 = s01 * LO2(R.w) + LO2(R.k) * R.v; s23 = s23 * HI2(R.w) + HI2(R.k) * R.v; } \
                f32x2 qq_ = s01 * LO2(R.r); qq_ = s23 * HI2(R.r) + qq_; yp[(t) * 256] = qq_.x + qq_.y; } while (0)
            ScanRec A, B, C, E;
            C_LD(A, 0); C_LD(B, 1);
#define C_8(t) do { C_LD(C, (t) + 2); C_STEP(A, (t)); C_LD(E, (t) + 3); C_STEP(B, (t) + 1); C_LD(A, (t) + 4); C_STEP(C, (t) + 2); C_LD(B, (t) + 5); C_STEP(E, (t) + 3); \
                    C_LD(C, (t) + 6); C_STEP(A, (t) + 4); C_LD(E, (t) + 7); C_STEP(B, (t) + 5); C_LD(A, (t) + 8); C_STEP(C, (t) + 6); C_LD(B, (t) + 9); C_STEP(E, (t) + 7); } while (0)
            C_8(0);
            if (cd.nv > 8) { C_8(8); C_8(16); C_8(24); }
#undef C_8
#undef C_LD
#undef C_STEP
#undef SB_
            if (cc == (cit < 256 ? SEQ / CH - 1 : 0)) {
                const f32x4 s = (f32x4){s01.x, s01.y, s23.x, s23.y};
                if (RW) { float* So = OUTP() + (cd.samp ? OFF_RS + ((((size_t)li * 32 + cd.b) * 32 + cd.h) * 64 + cd.row0 + crow) * 64 : OFF_RP + ((((size_t)li * 2 + cd.b) * 32 + cd.h) * 64 + cd.row0 + crow) * 64) + 4 * cl;
                    *(f32x4*)So = s; }
                else { float* So = OUTP() + (cd.samp ? OFF_HS + (((size_t)li * 32 + cd.b) * 8 + cd.h) * 16384 : OFF_HP + (((size_t)li * 2 + cd.b) * 8 + cd.h) * 16384) + (size_t)(cd.kh * 64 + 4 * cl) * 128 + cd.row0 + crow;
                    So[0] = s[0]; So[128] = s[1]; So[256] = s[2]; So[384] = s[3]; }
            }
        } else {
            LAS float* nb = lds + ((q + 1) & 1) * (CH * REC);
            P_PUT(nb);
            P_LOAD();
            if (prevd.ok) P_REDUCE(prevd, (q + 1) & 1);
        }
        prevd = cd; scan_adv(cit, cc, gsz);
        __syncthreads();
    }
    if (!consumer && prevd.ok) P_REDUCE(prevd, (q + 1) & 1);
    __syncthreads();
#undef P_LOAD
#undef P_PUT
#undef P_REDUCE
#undef C_S0
}

constexpr int NHI = 2 * 8 * 64;
constexpr size_t WS_LBUF = WS_T + 256 * MiB, WS_DTOT = WS_T + 320 * MiB;
constexpr int RS128 = 136, RS64 = 72;
typedef short s16x4 __attribute__((ext_vector_type(4)));
__device__ __forceinline__ unsigned short bf1(float f) { return (unsigned short)(pk2(f, 0.f) & 0xffffu); }
#define HG_GATES(WANT_Q) \
    float gl[16], kg[16], qg[16]; \
    { float fqv[16], qav[16]; const float* src = PROJ + (size_t)(m0 + 16 * J) * IN_EVEN + h * 128 + k; \
      _Pragma("unroll") for (int jj = 0; jj < 16; ++jj) { fqv[jj] = src[(size_t)jj * IN_EVEN + 1024]; if (WANT_Q) qav[jj] = src[(size_t)jj * IN_EVEN]; } \
      float run = 0.f; \
      _Pragma("unroll") for (int jj = 0; jj < 16; ++jj) { const float sg = sigmoidf_(fqv[jj]); const float f = lb + (1.f - lb) * sg; run += __logf(f); gl[jj] = run; kg[jj] = (1.f - lb) * (1.f - sg); \
          if (WANT_Q) qg[jj] = qav[jj] * sigmoidf_(qav[jj]) * 0.08838834764831845f; else qg[jj] = 0.f; } \
      tots[J * 128 + k] = run; }

__device__ __forceinline__ void hgrn_h1(LAS unsigned char* lds8, const int e) {
    unsigned char* ws = WSP();
    const float* PROJ = (const float*)(ws + WS_PROJ);
    float* LBUF = (float*)(ws + WS_LBUF); float* DTOT = (float*)(ws + WS_DTOT);
    LAS unsigned short* KhT = (LAS unsigned short*)lds8;
    LAS unsigned short* VT = KhT + 128 * RS64;
    LAS float* tots = (LAS float*)(VT + 128 * RS64);
    const int tid = TID(), bid = BID(), gsz = GSZ(), lane = tid & 63, wave = rfl(tid >> 6);
    const int k = tid & 127, J = tid >> 7;
    for (int item = bid; item < NHI; item += gsz) {
        const int b = item >> 9, h = (item >> 6) & 7, c = item & 63, m0 = b * SEQ + c * 64;
        const float lb = e ? sigmoidf_(IN(13)[1024 + h * 128 + k] - IN(13)[h * 128 + k]) : 0.f;
        __syncthreads();
        HG_GATES(false)
        { const float* vs = PROJ + (size_t)(m0 + 16 * J) * IN_EVEN + 2048 + h * 128 + k;
#pragma unroll
          for (int jj = 0; jj < 16; ++jj) VT[k * RS64 + 16 * J + jj] = bf1(vs[(size_t)jj * IN_EVEN]); }
        __syncthreads();
        { const float t0 = tots[k], t1 = tots[128 + k], t2 = tots[256 + k], t3 = tots[384 + k];
          const float gs = J == 0 ? 0.f : (J == 1 ? t0 : (J == 2 ? t0 + t1 : t0 + t1 + t2)), glast = (t0 + t1) + (t2 + t3);
#pragma unroll
          for (int jj = 0; jj < 16; ++jj) KhT[k * RS64 + 16 * J + jj] = bf1(kg[jj] * __expf(glast - gs - gl[jj]));
          if (J == 0) DTOT[(size_t)item * 128 + k] = __expf(glast); }
        __syncthreads();
        f32x4 acc[8];
#pragma unroll
        for (int nt = 0; nt < 8; ++nt) acc[nt] = (f32x4){0.f, 0.f, 0.f, 0.f};
        const int fr = lane & 15, fq = lane >> 4;
#pragma unroll
        for (int s = 0; s < 2; ++s) {
            const bf16x8 a = *(const LAS bf16x8*)(KhT + (16 * wave + fr) * RS64 + 32 * s + 8 * fq);
#pragma unroll
            for (int nt = 0; nt < 8; ++nt) { const bf16x8 bb = *(const LAS bf16x8*)(VT + (16 * nt + fr) * RS64 + 32 * s + 8 * fq);
                acc[nt] = __builtin_amdgcn_mfma_f32_16x16x32_bf16(a, bb, acc[nt], 0, 0, 0); }
        }
        float* Lo = LBUF + (size_t)item * 16384 + (size_t)(16 * wave + 4 * fq) * 128 + fr;
#pragma unroll
        for (int nt = 0; nt < 8; ++nt)
#pragma unroll
            for (int r = 0; r < 4; ++r) Lo[r * 128 + 16 * nt] = acc[nt][r];
    }
    __syncthreads();
}

__device__ __forceinline__ void hgrn_h2(const int e) {
    unsigned char* ws = WSP();
    float* LBUF = (float*)(ws + WS_LBUF); const float* DTOT = (const float*)(ws + WS_DTOT);
    const int tid = TID(), bid = BID(), gsz = GSZ();
    typedef float f32x2h __attribute__((ext_vector_type(2)));
    for (int gid = bid * 512 + tid; gid < 16 * 128 * 64; gid += gsz * 512) {
        const int bh = gid >> 13, k = (gid >> 6) & 127, v2 = (gid & 63) * 2;
        f32x2h S = (f32x2h){0.f, 0.f};
        float* ptr = LBUF + (size_t)bh * 64 * 16384 + (size_t)k * 128 + v2; const float* dp = DTOT + (size_t)bh * 64 * 128 + k;
#pragma unroll 8
        for (int c = 0; c < 64; ++c) { const f32x2h t = *(const f32x2h*)(ptr + (size_t)c * 16384); const float d = dp[c * 128]; *(f32x2h*)(ptr + (size_t)c * 16384) = S; S = S * d + t; }
        *(f32x2h*)(OUTP() + OFF_HP + ((size_t)e * 16 + bh) * 16384 + (size_t)k * 128 + v2) = S;
    }
}

__device__ __forceinline__ void hgrn_h3(LAS unsigned char* lds8, const int e) {
    unsigned char* ws = WSP();
    const float* PROJ = (const float*)(ws + WS_PROJ);
    const float* LBUF = (const float*)(ws + WS_LBUF); float* O0 = (float*)(ws + WS_OPART);
    LAS unsigned short* Qt = (LAS unsigned short*)lds8;
    LAS unsigned short* Qb = Qt + 64 * RS128;
    LAS unsigned short* KT = Qb + 64 * RS128;
    LAS unsigned short* VT = KT + 160 * RS128;
    LAS unsigned short* ST = VT + 128 * RS64;
    LAS float* tots = (LAS float*)(ST + 128 * RS128);
    const int tid = TID(), bid = BID(), gsz = GSZ(), lane = tid & 63, wave = rfl(tid >> 6);
    const int k = tid & 127, J = tid >> 7;
    for (int item = bid; item < NHI; item += gsz) {
        const int b = item >> 9, h = (item >> 6) & 7, c = item & 63, m0 = b * SEQ + c * 64;
        const float lb = e ? sigmoidf_(IN(13)[1024 + h * 128 + k] - IN(13)[h * 128 + k]) : 0.f;
        __syncthreads();
        HG_GATES(true)
        { const float* vs = PROJ + (size_t)(m0 + 16 * J) * IN_EVEN + 2048 + h * 128 + k;
#pragma unroll
          for (int jj = 0; jj < 16; ++jj) VT[k * RS64 + 16 * J + jj] = bf1(vs[(size_t)jj * IN_EVEN]); }
        { const float* Sp = LBUF + (size_t)item * 16384;
#pragma unroll
          for (int i = 0; i < 8; ++i) { const int idx = tid + 512 * i, kk_ = idx >> 5, v4 = (idx & 31) * 4; const f32x4 sv = *(const f32x4*)(Sp + kk_ * 128 + v4);
              ST[(v4 + 0) * RS128 + kk_] = bf1(sv[0]); ST[(v4 + 1) * RS128 + kk_] = bf1(sv[1]); ST[(v4 + 2) * RS128 + kk_] = bf1(sv[2]); ST[(v4 + 3) * RS128 + kk_] = bf1(sv[3]); } }
        __syncthreads();
        { const float t0 = tots[k], t1 = tots[128 + k], t2 = tots[256 + k];
          const float gsI[4] = {0.f, t0, t0 + t1, t0 + t1 + t2};
          const float gs = J == 0 ? gsI[0] : (J == 1 ? gsI[1] : (J == 2 ? gsI[2] : gsI[3]));
#pragma unroll
          for (int jj = 0; jj < 16; ++jj) { const int i = 16 * J + jj;
              Qt[i * RS128 + k] = bf1(qg[jj] * __expf(gl[jj])); Qb[i * RS128 + k] = bf1(qg[jj] * __expf(gs + gl[jj]));
#pragma unroll
              for (int I = 0; I < 4; ++I) if (I >= J) { const int rb = 8 * I * (I + 1);
                  KT[(rb + i) * RS128 + k] = bf1(kg[jj] * __expf(fminf(gsI[I] - gs - gl[jj], 80.f))); } } }
        __syncthreads();
        const int fr = lane & 15, fq = lane >> 4;
        f32x4 acc[4];
#pragma unroll
        for (int I = 0; I < 4; ++I) acc[I] = (f32x4){0.f, 0.f, 0.f, 0.f};
#pragma unroll
        for (int ks = 0; ks < 4; ++ks) { const bf16x8 a = *(const LAS bf16x8*)(ST + (16 * wave + fr) * RS128 + 32 * ks + 8 * fq);
#pragma unroll
            for (int I = 0; I < 4; ++I) { const bf16x8 bb = *(const LAS bf16x8*)(Qb + (16 * I + fr) * RS128 + 32 * ks + 8 * fq);
                acc[I] = __builtin_amdgcn_mfma_f32_16x16x32_bf16(a, bb, acc[I], 0, 0, 0); } }
#pragma unroll
        for (int I = 0; I < 4; ++I) {
            const int rb = 8 * I * (I + 1);
            f32x4 P[4];
#pragma unroll
            for (int Jt = 0; Jt < 4; ++Jt) { P[Jt] = (f32x4){0.f, 0.f, 0.f, 0.f};
                if (Jt <= I) {
#pragma unroll
                    for (int ks = 0; ks < 4; ++ks) { const bf16x8 a = *(const LAS bf16x8*)(KT + (rb + 16 * Jt + fr) * RS128 + 32 * ks + 8 * fq);
                        const bf16x8 bb = *(const LAS bf16x8*)(Qt + (16 * I + fr) * RS128 + 32 * ks + 8 * fq);
                        P[Jt] = __builtin_amdgcn_mfma_f32_16x16x32_bf16(a, bb, P[Jt], 0, 0, 0); }
                    if (Jt == I) {
#pragma unroll
                        for (int r = 0; r < 4; ++r) P[Jt][r] = (4 * fq + r <= fr) ? P[Jt][r] : 0.f; }
                } }
#pragma unroll
            for (int s = 0; s < 2; ++s) if (2 * s <= I) {
                u32x4 pw; pw.x = pk2(P[2 * s][0], P[2 * s][1]); pw.y = pk2(P[2 * s][2], P[2 * s][3]); pw.z = pk2(P[2 * s + 1][0], P[2 * s + 1][1]); pw.w = pk2(P[2 * s + 1][2], P[2 * s + 1][3]);
                const s16x4 v0 = *(const LAS s16x4*)(VT + (16 * wave + fr) * RS64 + 32 * s + 4 * fq), v1 = *(const LAS s16x4*)(VT + (16 * wave + fr) * RS64 + 32 * s + 16 + 4 * fq);
                const bf16x8 a = (bf16x8){v0[0], v0[1], v0[2], v0[3], v1[0], v1[1], v1[2], v1[3]};
                acc[I] = __builtin_amdgcn_mfma_f32_16x16x32_bf16(a, __builtin_bit_cast(bf16x8, pw), acc[I], 0, 0, 0); }
        }
#pragma unroll
        for (int I = 0; I < 4; ++I) *(f32x4*)(O0 + (size_t)(m0 + 16 * I + fr) * 1024 + h * 128 + 16 * wave + 4 * fq) = acc[I];
    }
    __syncthreads();
}

constexpr int KROWS = 160, SW_KS = 72, SW_VS = 168;
__device__ __forceinline__ void swa_phase(const Params& p, LAS unsigned char* lds8, const int e) {
    unsigned char* ws = WSP();
    LAS unsigned short* Kb = (LAS unsigned short*)lds8; LAS unsigned short* VTb = Kb + KROWS * SW_KS; LAS float* biasT = (LAS float*)(VTb + 64 * SW_VS);
    const float* PROJ = (const float*)(ws + WS_PROJ);
    const float* cK = IN(3) + (size_t)e * 32 * 128 * 256; const float* cV = IN(4) + (size_t)e * 32 * 128 * 256;
    bf16_t* MA = (bf16_t*)(ws + WS_MA);
    const int tid = TID(), bid = BID(), gsz = GSZ(), lane = tid & 63, wave = rfl(tid >> 6), fr = lane & 15, fq = lane >> 4;
    for (int item = bid; item < 1024 + 128; item += gsz) {
        const bool samp = item >= 1024;
        int b, kh, q0 = 0;
        if (!samp) { b = item >> 9; kh = (item >> 7) & 3; q0 = (item & 127) * 32; } else { const int ii = item - 1024; b = ii >> 2; kh = ii & 3; }
        __syncthreads();
        for (int idx = tid; idx < KROWS * 16; idx += 512) {
            const int r = idx >> 4, c = (idx & 15) * 4;
            f32x4 kv = (f32x4){0.f, 0.f, 0.f, 0.f}, vv = kv;
            if (!samp) { const int pos = q0 - 127 + r; if (pos >= 0 && r < 159) { const float* src = PROJ + (size_t)(b * SEQ + pos) * IN_EVEN + 5120 + kh * 64 + c; kv = *(const f32x4*)src; vv = *(const f32x4*)(src + 256); } }
            else if (r < 128) { const size_t o_ = ((size_t)b * 128 + r) * 256 + kh * 64 + c; kv = *(const f32x4*)(cK + o_); vv = *(const f32x4*)(cV + o_); }
            else if (r < 136) { const float* src = PROJ + (size_t)(MP + b * DSEQ + r - 128) * IN_EVEN + 5120 + kh * 64 + c; kv = *(const f32x4*)src; vv = *(const f32x4*)(src + 256); }
            u32x2 kw; kw.x = pk2(kv[0], kv[1]); kw.y = pk2(kv[2], kv[3]); *(LAS u32x2*)(Kb + r * SW_KS + c) = kw;
            VTb[(c + 0) * SW_VS + r] = bf1(vv[0]); VTb[(c + 1) * SW_VS + r] = bf1(vv[1]); VTb[(c + 2) * SW_VS + r] = bf1(vv[2]); VTb[(c + 3) * SW_VS + r] = bf1(vv[3]);
        }
        { const int d = tid >> 2, hh = tid & 3; int bkt = d;
          if (d >= 16) { bkt = 16 + (int)(logf((float)d * 0.0625f) * (16.0f / 2.0794415416798357f)); bkt = bkt > 31 ? 31 : bkt; }
          biasT[tid] = IN(15)[bkt * 16 + kh * 4 + hh]; }
        __syncthreads();
        const int hh = wave >> 1, sub = wave & 1;
        const bool active = !samp || (sub == 0);
        if (active) {
            const int qi = 16 * sub + fr;
            const bool qreal = !samp || qi < 8;
            const int rq = samp ? 128 + qi : 127 + qi;
            const int mtok = samp ? MP + b * DSEQ + (qi & 7) : b * SEQ + q0 + qi;
            const int head = kh * 4 + hh;
            const float sink = IN(16)[e * 16 + head];
            bf16x8 qf[2];
            { const float* qp = PROJ + (size_t)mtok * IN_EVEN + 4096 + head * 64 + 8 * fq;
#pragma unroll
              for (int ks = 0; ks < 2; ++ks) { const f32x4 a = *(const f32x4*)(qp + 32 * ks) * 0.125f, c2 = *(const f32x4*)(qp + 32 * ks + 4) * 0.125f;
                  u32x4 w; w.x = pk2(a[0], a[1]); w.y = pk2(a[2], a[3]); w.z = pk2(c2[0], c2[1]); w.w = pk2(c2[2], c2[3]); qf[ks] = __builtin_bit_cast(bf16x8, w); } }
            const int kt0 = samp ? 0 : sub;
            f32x4 S[10]; float mloc = -1e30f;
#pragma unroll
            for (int t = 0; t < 10; ++t) {
                S[t] = (f32x4){0.f, 0.f, 0.f, 0.f};
                if (t < 9) {
#pragma unroll
                    for (int ks = 0; ks < 2; ++ks) { const bf16x8 a = *(const LAS bf16x8*)(Kb + (16 * (kt0 + t) + fr) * SW_KS + 32 * ks + 8 * fq);
                        S[t] = __builtin_amdgcn_mfma_f32_16x16x32_bf16(a, qf[ks], S[t], 0, 0, 0); }
                }
#pragma unroll
                for (int r = 0; r < 4; ++r) { const int R = 16 * (kt0 + t) + 4 * fq + r, d = rq - R;
                    const bool valid = (t < 9) && d >= 0 && d < 128 && (samp || (q0 - 127 + R >= 0));
                    const float sv = valid ? S[t][r] + biasT[(d & 127) * 4 + hh] : -1e30f;
                    S[t][r] = sv; mloc = fmaxf(mloc, sv); }
            }
            mloc = fmaxf(mloc, __shfl_xor(mloc, 16)); mloc = fmaxf(mloc, __shfl_xor(mloc, 32));
            const float mt = fmaxf(mloc, sink);
            float l = 0.f;
#pragma unroll
            for (int t = 0; t < 10; ++t)
#pragma unroll
                for (int r = 0; r < 4; ++r) { const float pp = __expf(S[t][r] - mt); S[t][r] = pp; l += pp; }
            l += __shfl_xor(l, 16); l += __shfl_xor(l, 32);
            const float inv = 1.f / (l + __expf(sink - mt));
            f32x4 O[4];
#pragma unroll
            for (int dt = 0; dt < 4; ++dt) O[dt] = (f32x4){0.f, 0.f, 0.f, 0.f};
#pragma unroll
            for (int s = 0; s < 5; ++s) {
                u32x4 pw; pw.x = pk2(S[2 * s][0], S[2 * s][1]); pw.y = pk2(S[2 * s][2], S[2 * s][3]); pw.z = pk2(S[2 * s + 1][0], S[2 * s + 1][1]); pw.w = pk2(S[2 * s + 1][2], S[2 * s + 1][3]);
                const bf16x8 pb = __builtin_bit_cast(bf16x8, pw);
#pragma unroll
                for (int dt = 0; dt < 4; ++dt) {
                    const LAS unsigned short* vp = VTb + (16 * dt + fr) * SW_VS + 16 * (kt0 + 2 * s) + 4 * fq;
                    const s16x4 v0 = *(const LAS s16x4*)vp; s16x4 v1 = (s16x4){0, 0, 0, 0}; if (s < 4) v1 = *(const LAS s16x4*)(vp + 16);
                    const bf16x8 a = (bf16x8){v0[0], v0[1], v0[2], v0[3], v1[0], v1[1], v1[2], v1[3]};
                    O[dt] = __builtin_amdgcn_mfma_f32_16x16x32_bf16(a, pb, O[dt], 0, 0, 0); }
            }
            if (qreal) {
                bf16_t* dst = MA + (size_t)mtok * D + 1024 + head * 64 + 4 * fq;
#pragma unroll
                for (int dt = 0; dt < 4; ++dt) { u32x2 w; w.x = pk2(O[dt][0] * inv, O[dt][1] * inv); w.y = pk2(O[dt][2] * inv, O[dt][3] * inv); *(u32x2*)(dst + 16 * dt) = w; }
            }
        }
    }
    const int gt = bid * 512 + tid, ngt = gsz * 512;
    for (int idx = gt; idx < 2 * 128 * 64; idx += ngt) {
        const int b = idx >> 13, w = (idx >> 6) & 127, c = (idx & 63) * 4;
        const float* src = PROJ + (size_t)(b * SEQ + SEQ - 128 + w) * IN_EVEN + 5120 + c;
        const size_t o_ = (((size_t)e * 2 + b) * 128 + w) * 256 + c;
        *(f32x4*)(OUTP() + OFF_KP + o_) = *(const f32x4*)src; *(f32x4*)(OUTP() + OFF_VP + o_) = *(const f32x4*)(src + 256);
    }
    for (int idx = gt; idx < 32 * 128 * 64; idx += ngt) {
        const int b = idx >> 13, w = (idx >> 6) & 127, c = (idx & 63) * 4;
        f32x4 kv, vv;
        if (w < 120) { const size_t s_ = ((size_t)b * 128 + w + 8) * 256 + c; kv = *(const f32x4*)(cK + s_); vv = *(const f32x4*)(cV + s_); }
        else { const float* src = PROJ + (size_t)(MP + b * DSEQ + w - 120) * IN_EVEN + 5120 + c; kv = *(const f32x4*)src; vv = *(const f32x4*)(src + 256); }
        const size_t o_ = (((size_t)e * 32 + b) * 128 + w) * 256 + c;
        *(f32x4*)(OUTP() + OFF_KS + o_) = kv; *(f32x4*)(OUTP() + OFF_VS + o_) = vv;
    }
}

__device__ __forceinline__ void put_job(LAS unsigned char* lds, int j, const void* A, const void* B, void* C, int nN, int ldc, int mode, int& start, int ks = 1, const void* bias = nullptr) {
    LAS pg8::Job* jb = (LAS pg8::Job*)(lds + JOBS_OFF) + j;
    asm volatile("" : "+s"(nN), "+s"(ldc), "+s"(mode), "+s"(ks));
    jb->A = (unsigned long long)A; jb->B = (unsigned long long)B; jb->C = (unsigned long long)C; jb->nN = nN; jb->ldc = ldc; jb->mode = mode; jb->start = start; jb->ks = ks; jb->pad = 0; jb->bias = (unsigned long long)bias;
    start += ks > 1 ? (M / 256 - 1) * nN + nN * ks : (M / 256) * nN;
}
enum { G_IN = 0, G_OUT = 1, G_UP = 2, G_DOWN = 3, G_RKV = 4, G_L2 = 5, G_WO = 6, MIX_E = 7, ROW_HG = 8, ROW_P1 = 9, MIX_O = 10, ROW_GN = 11, HG_H2 = 13, HG_H3 = 14 };

__device__ __forceinline__ int setup_jobs(const Params& p, LAS unsigned char* lds, int kind, int layer) {
    unsigned char* ws = WSP(); const bf16_t* WB = (const bf16_t*)(ws + WS_WB);
    const int o = layer >> 1;
    int K = 2048;
    if (TID() == 0) {
        int start = 0, nj = 0;
        const bf16_t* HB = (const bf16_t*)(ws + WS_HB); const bf16_t* MA = (const bf16_t*)(ws + WS_MA);
        if (kind == G_IN) put_job(lds, nj++, HB, WB + WB_WIN, ws + WS_PROJ, IN_EVEN / 256, IN_EVEN, 0, start);
        else if (kind == G_OUT) put_job(lds, nj++, MA, WB + WB_WOUT, ws + WS_MIX, 8, D, 1, start, KSPLIT);
        else if (kind == G_UP) put_job(lds, nj++, HB, WB + WB_UP, ws + WS_HID, 32, 8192, 2, start);
        else if (kind == G_DOWN) put_job(lds, nj++, ws + WS_HID, WB + WB_DOWN, ws + WS_MIX, 8, D, 1, start, KSPLIT);
        else if (kind == G_WO) put_job(lds, nj++, MA, WB + WB_WO, ws + WS_MIX, 8, D, 1, start, KSPLIT);
        else if (kind == G_RKV) {
            const bf16_t* XM = (const bf16_t*)(ws + WS_XMIX); const size_t MD = (size_t)M * D;
            put_job(lds, nj++, XM + 0 * MD, WB + WB_WR, ws + WS_R, 8, D, 0, start);
            put_job(lds, nj++, XM + 2 * MD, WB + WB_WK, ws + WS_K, 8, D, 0, start);
            put_job(lds, nj++, XM + 3 * MD, WB + WB_WV, ws + (o == 0 ? WS_VF : WS_V3), 8, D, 0, start);
            put_job(lds, nj++, XM + 1 * MD, WB + WB_L1 + 0 * 524288, ws + WS_MA + 0 * MID_BYTES, 1, 256, 3, start);
            put_job(lds, nj++, XM + 4 * MD, WB + WB_L1 + 1 * 524288, ws + WS_MA + 1 * MID_BYTES, 1, 256, 1, start);
            put_job(lds, nj++, XM + 5 * MD, WB + WB_L1 + 3 * 524288, ws + WS_MA + 3 * MID_BYTES, 1, 256, 4, start);
            if (o) put_job(lds, nj++, XM + 3 * MD, WB + WB_L1 + 2 * 524288, ws + WS_MA + 2 * MID_BYTES, 1, 256, 1, start);
        } else if (kind == G_L2) {
            put_job(lds, nj++, ws + WS_MA + 0 * MID_BYTES, WB + WB_L2 + 0 * 524288, ws + WS_W2O, 8, D, 5, start, 1, IN(22) + (size_t)o * D);
            put_job(lds, nj++, ws + WS_MA + 1 * MID_BYTES, WB + WB_L2 + 1 * 524288, ws + WS_A2O, 8, D, 6, start, 1, IN(25) + (size_t)o * D);
            put_job(lds, nj++, ws + WS_MA + 3 * MID_BYTES, WB + WB_L2 + 3 * 524288, ws + WS_HB, 8, D, 1, start);
            if (o) put_job(lds, nj++, ws + WS_MA + 2 * MID_BYTES, WB + WB_L2 + 2 * 524288, ws + WS_V2O, 8, D, 6, start, 1, IN(28) + (size_t)(o - 1) * D);
        }
        LAS int* hdr = (LAS int*)(lds + HDR_OFF); hdr[0] = nj; hdr[1] = start;
    }
    if (kind == G_DOWN) K = 8192;
    if (kind == G_L2) K = 256;
    return K;
}

__global__ void __launch_bounds__(512, 2) mega_fwd(Params p) {
    extern __shared__ __attribute__((aligned(16))) unsigned char lds_raw[];
    LAS unsigned char* lds = (LAS unsigned char*)lds_raw;
    cg::grid_group grid = cg::this_grid();
    unsigned* xbar = (unsigned*)(WSP() + WS_BAR);
    volatile LAS unsigned* xst = (volatile LAS unsigned*)(lds + LDS_BYTES - 16);
    if (threadIdx.x < 2) xst[threadIdx.x] = 0u;
    if (threadIdx.x == 0) (void)xb_add(&xbar[XB_XCNT(xb_xcc_id())], 1u);
    if (gridDim.x == 0) grid.sync();
    __syncthreads();
    unsigned char* ws = WSP();
    for (int layer = 0; layer <= 4; ++layer) {
#ifndef DBG_NO_CONV
        if (layer < 4) {
            bf16_t* WB = (bf16_t*)(ws + WS_WB);
            const int tid_ = TID(), lane = tid_ & 63, wave = rfl(tid_ >> 6), gw = BID() * 8 + wave, ngw = GSZ() * 8;
            LAS float* scr = (LAS float*)(lds + wave * 16384);
            const int o = layer >> 1, e = layer >> 1;
            conv_mat(IN(38) + (size_t)layer * 16777216, 2048, 8192, WB + WB_UP, 2048, 8192, scr, gw, ngw, lane);
            conv_mat(IN(39) + (size_t)layer * 16777216, 8192, 2048, WB + WB_DOWN, 8192, 2048, scr, gw, ngw, lane);
            if ((layer & 1) == 0) {
                conv_mat(IN(11) + (size_t)e * 2048 * IN_EVEN, 2048, IN_EVEN, WB + WB_WIN, 2048, IN_EVEN, scr, gw, ngw, lane);
                conv_mat(IN(12) + (size_t)e * 4194304, 2048, 2048, WB + WB_WOUT, 2048, 2048, scr, gw, ngw, lane);
            } else {
                conv_mat(IN(18) + (size_t)o * 4194304, 2048, 2048, WB + WB_WR, 2048, 2048, scr, gw, ngw, lane);
                conv_mat(IN(19) + (size_t)o * 4194304, 2048, 2048, WB + WB_WK, 2048, 2048, scr, gw, ngw, lane);
                conv_mat(IN(20) + (size_t)o * 4194304, 2048, 2048, WB + WB_WV, 2048, 2048, scr, gw, ngw, lane);
                conv_mat(IN(21) + (size_t)o * 4194304, 2048, 2048, WB + WB_WO, 2048, 2048, scr, gw, ngw, lane);
                conv_mat(IN(23) + (size_t)o * 2048 * 96, 2048, 96, WB + WB_L1 + 0 * 524288, 2048, 256, scr, gw, ngw, lane);
                conv_mat(IN(26) + (size_t)o * 2048 * 96, 2048, 96, WB + WB_L1 + 1 * 524288, 2048, 256, scr, gw, ngw, lane);
                conv_mat(IN(31) + (size_t)o * 2048 * 256, 2048, 256, WB + WB_L1 + 3 * 524288, 2048, 256, scr, gw, ngw, lane);
                conv_mat(IN(24) + (size_t)o * 96 * 2048, 96, 2048, WB + WB_L2 + 0 * 524288, 256, 2048, scr, gw, ngw, lane);
                conv_mat(IN(27) + (size_t)o * 96 * 2048, 96, 2048, WB + WB_L2 + 1 * 524288, 256, 2048, scr, gw, ngw, lane);
                conv_mat(IN(32) + (size_t)o * 256 * 2048, 256, 2048, WB + WB_L2 + 3 * 524288, 256, 2048, scr, gw, ngw, lane);
                if (o) {
                    conv_mat(IN(29) + (size_t)(o - 1) * 2048 * 64, 2048, 64, WB + WB_L1 + 2 * 524288, 2048, 256, scr, gw, ngw, lane);
                    conv_mat(IN(30) + (size_t)(o - 1) * 64 * 2048, 64, 2048, WB + WB_L2 + 2 * 524288, 256, 2048, scr, gw, ngw, lane);
                }
            }
        }
#endif
#ifndef DBG_NO_ROWPRE
        row_pre(p, layer);
#endif
        if (layer == 4) break;
        xcd_barrier(xbar, xst);
        const bool odd = layer & 1;
        const int nsub = odd ? 8 : 9;
        const unsigned long long seq = odd ? 0x3296BA54ull : 0x32918ED70ull;
        for (int sidx = 0; sidx < nsub; ++sidx) {
            const int kind = (int)((seq >> (4 * sidx)) & 15ull);
            if (kind <= G_WO) {
                __syncthreads();
                const int K = setup_jobs(p, lds, kind, layer);
                __syncthreads();
#ifndef DBG_NO_GEMM
                pg8::gemm_phase(lds, K, GSZ(), BID());
#endif
            } else if (kind == MIX_E) {
#ifndef DBG_NO_SCANE
                hgrn_h1(lds, layer >> 1);
                scan_phase<false>(p, lds, layer >> 1, 256);
#ifdef PROBE_DUP_SCAN
                __syncthreads();
                scan_phase<false>(p, lds, layer >> 1);
#endif
#endif
                __syncthreads();
#ifndef DBG_NO_SWA
                swa_phase(p, lds, layer >> 1);
#ifdef PROBE_DUP_SWA
                __syncthreads();
                swa_phase(p, lds, layer >> 1);
#endif
#endif
            } else if (kind == HG_H2) { hgrn_h2(layer >> 1);
            } else if (kind == HG_H3) { hgrn_h3(lds, layer >> 1);
            } else if (kind == ROW_HG) {
#ifndef DBG_NO_ROWHG
                row_hg(p, layer >> 1);
#endif
            } else if (kind == ROW_P1) {
#ifndef DBG_NO_ROWP1
                row_post1(p, layer);
#endif
            }
            else if (kind == MIX_O) {
#ifndef DBG_NO_SCANO
                scan_phase<true>(p, lds, layer >> 1);
#ifdef PROBE_DUP_SCAN
                __syncthreads();
                scan_phase<true>(p, lds, layer >> 1);
#endif
#endif
            }
            else {
#ifndef DBG_NO_ROWGN
                row_gn(p, layer);
#endif
            }
            xcd_barrier(xbar, xst);
        }
    }
}

extern "C" void kernel_launch(void* const* d_in, const int* in_sizes, int n_in, void* d_out, int out_size, void* d_ws, size_t ws_size, hipStream_t stream) {
    static int grid = 0;
    if (grid == 0) {
        if (n_in != 40 || ws_size < WS_END) { fprintf(stderr, "kernel_launch: unexpected n_in %d or ws_size %zu (< %zu)\n", n_in, ws_size, (size_t)WS_END); grid = -1; return; }
        int dev = 0, cus = 0, per_cu = 0;
        hipGetDevice(&dev);
        hipDeviceGetAttribute(&cus, hipDeviceAttributeMultiprocessorCount, dev);
        if (hipFuncSetAttribute((const void*)mega_fwd, hipFuncAttributeMaxDynamicSharedMemorySize, LDS_BYTES) != hipSuccess) { fprintf(stderr, "kernel_launch: hipFuncSetAttribute failed\n"); grid = -1; return; }
        hipOccupancyMaxActiveBlocksPerMultiprocessor(&per_cu, (const void*)mega_fwd, 512, LDS_BYTES);
        if (per_cu < 1) { fprintf(stderr, "kernel_launch: occupancy query says %d blocks/CU\n", per_cu); per_cu = 1; }
        (void)hipGetLastError();
        grid = cus;
    }
    if (grid < 0) return;
    Params p{};
    for (int i = 0; i < 40; ++i) p.in[i] = (const float*)d_in[i];
    p.out = (float*)d_out; p.ws = (unsigned char*)d_ws;
    if (hipMemsetAsync((char*)d_ws + WS_BAR, 0, XCD_BAR_WORDS * 4, stream) != hipSuccess) { fprintf(stderr, "kernel_launch: hipMemsetAsync of the barrier words failed\n"); return; }
    void* args[] = {&p};
    hipError_t e = hipLaunchCooperativeKernel((const void*)mega_fwd, dim3(grid), dim3(512), args, LDS_BYTES, stream);
    if (e != hipSuccess) fprintf(stderr, "kernel_launch: cooperative launch failed: %s (grid %d)\n", hipGetErrorString(e), grid);
}
```

```cpp
#include <hip/hip_runtime.h>
#include <hip/hip_cooperative_groups.h>
#include <cstdio>
#include <cstdint>
#include <cmath>
namespace cg = cooperative_groups;

#define LAS __attribute__((address_space(3)))
typedef unsigned short bf16_t;
typedef short bf16x8 __attribute__((ext_vector_type(8)));
typedef float f32x4 __attribute__((ext_vector_type(4)));
typedef unsigned u32x4 __attribute__((ext_vector_type(4)));
typedef unsigned u32x2 __attribute__((ext_vector_type(2)));

constexpr int D = 2048, MP = 8192, MS = 256, M = MP + MS, SEQ = 4096, DSEQ = 8;
constexpr int IN_EVEN = 5632;
constexpr size_t MiB = 1u << 20;
constexpr size_t WS_WB = 0, WS_XA = 104 * MiB, WS_XB = 170 * MiB, WS_HB = 236 * MiB, WS_MIX = 269 * MiB, WS_MA = 335 * MiB, WS_VF = 368 * MiB, WS_T = 434 * MiB;
constexpr size_t WS_PROJ = WS_T, WS_OPART = WS_T + 182 * MiB, WS_HID = WS_T;
constexpr size_t WS_XMIX = WS_T, WS_W2O = WS_T, WS_A2O = WS_T + 66 * MiB, WS_V2O = WS_T + 132 * MiB;
constexpr size_t WS_R = WS_T + 198 * MiB, WS_K = WS_T + 264 * MiB, WS_V3 = WS_T + 330 * MiB, WS_PB = WS_T + 396 * MiB, WS_BAR = WS_PB + 32 * MiB, WS_END = WS_BAR + 1 * MiB;
constexpr int KSPLIT = 16;
constexpr size_t MID_BYTES = (size_t)M * 256 * 2;
constexpr size_t WB_UP = 0, WB_DOWN = 16777216, WB_REST = 33554432;
constexpr size_t WB_WIN = WB_REST, WB_WOUT = WB_REST + 11534336;
constexpr size_t WB_WR = WB_REST, WB_WK = WB_REST + 4194304, WB_WV = WB_REST + 8388608, WB_WO = WB_REST + 12582912, WB_L1 = WB_REST + 16777216, WB_L2 = WB_REST + 18874368;
constexpr size_t OFF_YP = 0, OFF_YS = 16777216, OFF_HP = 17301504, OFF_HS = 17825792, OFF_KP = 26214400, OFF_KS = 26345472, OFF_VP = 28442624, OFF_VS = 28573696,
                 OFF_RP = 30670848, OFF_RS = 31195136, OFF_SP = 39583744, OFF_SS = 39591936;
constexpr int RING_BYTES = 131072, JOBS_OFF = 131072, HDR_OFF = JOBS_OFF + 512, LDS_BYTES = 163840;

struct Params {
    const float* in[40];
    float* out;
    unsigned char* ws;
};


__device__ __forceinline__ const float* IN(int i) {
    int off = i * 8; asm volatile("" : "+s"(off));
    const __attribute__((address_space(4))) char* ka = (const __attribute__((address_space(4))) char*)__builtin_amdgcn_kernarg_segment_ptr();
    return *(const float* const __attribute__((address_space(4)))*)(ka + off);
}
__device__ __forceinline__ float* OUTP() { return (float*)IN(40); }
__device__ __forceinline__ unsigned char* WSP() { return (unsigned char*)IN(41); }


__device__ __forceinline__ int TID() { int t = threadIdx.x; asm volatile("" : "+v"(t)); return t; }
__device__ __forceinline__ int BID() { int b = blockIdx.x; asm volatile("" : "+s"(b)); return b; }
__device__ __forceinline__ int GSZ() { int g = gridDim.x; asm volatile("" : "+s"(g)); return g; }

__device__ __forceinline__ unsigned f2bf(float f) { unsigned u = __builtin_bit_cast(unsigned, f); return (u + 0x7fffu + ((u >> 16) & 1u)) >> 16; }
typedef float f32x2c __attribute__((ext_vector_type(2))); typedef __bf16 bf16x2c __attribute__((ext_vector_type(2)));
__device__ __forceinline__ unsigned pk2(float lo, float hi) { f32x2c v = {lo, hi}; return __builtin_bit_cast(unsigned, __builtin_convertvector(v, bf16x2c)); }
__device__ __forceinline__ float wave_sum(float v) {
#pragma unroll
    for (int o = 1; o < 64; o <<= 1) v += __shfl_xor(v, o);
    return v;
}
template <int CTRL> __device__ __forceinline__ float dppf(float v) {
    return __builtin_bit_cast(float, __builtin_amdgcn_update_dpp(0, __builtin_bit_cast(int, v), CTRL, 0xF, 0xF, true));
}
__device__ __forceinline__ float red16(float v) {
    v += dppf<0xB1>(v); v += dppf<0x4E>(v); v += dppf<0x141>(v); v += dppf<0x140>(v);
    return v;
}
__device__ __forceinline__ float red4(float v) { v += dppf<0xB1>(v); v += dppf<0x4E>(v); return v; }
__device__ __forceinline__ float max4(float v) { v = fmaxf(v, dppf<0xB1>(v)); v = fmaxf(v, dppf<0x4E>(v)); return v; }
__device__ __forceinline__ float sigmoidf_(float x) { return __builtin_amdgcn_rcpf(1.0f + __expf(-x)); }
__device__ __forceinline__ int rfl(int v) { return __builtin_amdgcn_readfirstlane(v); }
__device__ __forceinline__ const char* rfl_ptr(unsigned long long v) {
    unsigned lo = (unsigned)rfl((int)(unsigned)v), hi = (unsigned)rfl((int)(unsigned)(v >> 32));
    return (const char*)(((unsigned long long)hi << 32) | lo);
}


#define XB_TMO      128
#define XB_XCNT(j)  (256  + 64 * (j))
#define XB_XSUB(j)  (1280 + 64 * (j))
#define XB_XGEN(j)  (2304 + 64 * (j))
#define XB_TOP      3328
#define XB_TOPGEN   3392
#define XCD_BAR_WORDS 3456
#define XB_SPIN_CAP (1u << 18)
__device__ __forceinline__ unsigned xb_ld(unsigned* p)              { return __hip_atomic_load(p, __ATOMIC_RELAXED, __HIP_MEMORY_SCOPE_AGENT); }
__device__ __forceinline__ unsigned xb_add(unsigned* p, unsigned v) { return __hip_atomic_fetch_add(p, v, __ATOMIC_RELAXED, __HIP_MEMORY_SCOPE_AGENT); }
__device__ __forceinline__ unsigned xb_xcc_id() { return (unsigned)__builtin_amdgcn_s_getreg((3 << 11) | 20) & 0xFu; }
#define XB_SPIN(cond, bar) do { unsigned _sp = 0; while (cond) { __builtin_amdgcn_s_sleep(1); \
    if ((++_sp & 255u) == 0u) { if (xb_ld(&(bar)[XB_TMO])) break; if (_sp > XB_SPIN_CAP) { atomicAdd(&(bar)[XB_TMO], 1u); break; } } } } while (0)
__device__ __forceinline__ void xcd_barrier_complete(unsigned* bar, unsigned x, unsigned& nloc, unsigned& nx) {
    const unsigned G = gridDim.x * gridDim.y * gridDim.z;
    unsigned sum, cnt, mine, sp = 0u;
    for (;;) {
        sum = 0u; cnt = 0u; mine = 0u;
#pragma unroll
        for (unsigned j = 0; j < 16; ++j) { const unsigned c = xb_ld(&bar[XB_XCNT(j)]); sum += c; cnt += (c > 0u) ? 1u : 0u; mine = (j == x) ? c : mine; }
        if (sum == G) break;
        __builtin_amdgcn_s_sleep(1);
        if ((++sp & 255u) == 0u) { if (xb_ld(&bar[XB_TMO])) break; if (sp > XB_SPIN_CAP) { atomicAdd(&bar[XB_TMO], 1u); break; } }
    }
    nloc = mine > 0u ? mine : 1u; nx = cnt > 0u ? cnt : 1u;
}
__device__ __forceinline__ void xcd_barrier(unsigned* bar, volatile LAS unsigned* st) {
    asm volatile("s_waitcnt vmcnt(0)" ::: "memory");
    __syncthreads();
    if (threadIdx.x == 0) {
        const unsigned x = xb_xcc_id();
        __builtin_amdgcn_s_waitcnt(0);
        unsigned nloc = st[0], nx = st[1];
        if (nloc == 0u) { xcd_barrier_complete(bar, x, nloc, nx); st[0] = nloc; st[1] = nx; }
        const unsigned old = xb_add(&bar[XB_XSUB(x)], 1u);
        const unsigned gen = old / nloc;
        if (old + 1u == (gen + 1u) * nloc) {
            __builtin_amdgcn_fence(__ATOMIC_RELEASE, "agent");
            asm volatile("s_waitcnt vmcnt(0)" ::: "memory");
            const unsigned og = xb_add(&bar[XB_TOP], 1u);
            const unsigned tg = og / nx;
            if (og + 1u == (tg + 1u) * nx) xb_add(&bar[XB_TOPGEN], 1u);
            else XB_SPIN(xb_ld(&bar[XB_TOPGEN]) == tg, bar);
            __builtin_amdgcn_fence(__ATOMIC_ACQUIRE, "agent");
            xb_add(&bar[XB_XGEN(x)], 1u);
            asm volatile("s_waitcnt vmcnt(0)" ::: "memory");
        } else {
            XB_SPIN(xb_ld(&bar[XB_XGEN(x)]) == gen, bar);
            __builtin_amdgcn_fence(__ATOMIC_ACQUIRE, "agent");
            asm volatile("s_waitcnt vmcnt(0)" ::: "memory");
        }
    }
    __syncthreads();
}

namespace pg8 {
constexpr int BM = 256, BK = 64, HALF = 128, HTB = HALF * BK * 2, NXCD = 8, WGM = 8;
__device__ __forceinline__ int lds_byte(int r, int c) { const int st = (r >> 4) * 2 + (c >> 5), rr = r & 15, cc = c & 31, ob = rr * 64 + cc * 2; return st * 1024 + (ob ^ (((ob >> 9) & 1) << 5)); }
__device__ __forceinline__ void stage_rc(int b, int& R, int& C) { const int st = b / 1024, sb = b % 1024, swz = sb ^ (((sb >> 9) & 1) << 5); R = (st >> 1) * 16 + swz / 64; C = (st & 1) * 32 + (swz % 64) / 2; }

struct Job { unsigned long long A, B, C, bias; int nN, ldc, mode, start, ks, pad; };
struct Unit { int pm, pn, j, part, nt; const char* A; const char* B; };

__device__ __forceinline__ bool unit_next(LAS unsigned char* lds, int i, int G, int c, int K, Unit& u) {
    const LAS int* hdr = (const LAS int*)(lds + HDR_OFF);
    const LAS Job* jobs = (const LAS Job*)(lds + JOBS_OFF);
    const int njobs = rfl(hdr[0]), total = rfl(hdr[1]);
    const long L = (long)i * G + c; if (L >= total) return false;
    int l = (int)L, j = 0;
    for (int jj = 1; jj < njobs; ++jj) { if (l >= rfl(jobs[jj].start)) j = jj; }
    l -= rfl(jobs[j].start);
    const int nN = rfl(jobs[j].nN), ks = rfl(jobs[j].ks);
    const int nM = ks > 1 ? (M / BM - 1) : (M / BM), nwg = nM * nN;
    const size_t tstep = (size_t)BM * K * 2;
    const char* A = rfl_ptr(jobs[j].A); const char* B = rfl_ptr(jobs[j].B);
    u.j = j;
    if (l < nwg) {
        int wgid = l; { const int q = nwg / NXCD, r = nwg % NXCD, xcd = wgid % NXCD, off = wgid / NXCD; wgid = (xcd < r ? xcd * (q + 1) : r * (q + 1) + (xcd - r) * q) + off; }
        const int nig = WGM * nN, gid = wgid / nig, fm = gid * WGM, gsz = (nM - fm) < WGM ? (nM - fm) : WGM;
        u.pm = fm + ((wgid % nig) % gsz); u.pn = (wgid % nig) / gsz; u.part = -1; u.nt = K / BK;
        u.A = A + (size_t)u.pm * tstep; u.B = B + (size_t)u.pn * tstep;
    } else {
        const int l2 = l - nwg; u.pm = M / BM - 1; u.pn = l2 / ks; u.part = l2 % ks; u.nt = K / BK / ks;
        const size_t k0 = (size_t)u.part * (K / ks) * 2;
        u.A = A + (size_t)u.pm * tstep + k0; u.B = B + (size_t)u.pn * tstep + k0;
    }
    return true;
}

__device__ __forceinline__ float act_fn(float v, int mode) {
    if (mode == 2) { v = fmaxf(v, 0.f); return v * v; }
    if (mode == 3) { const float e = __expf(2.f * v); return 1.f - 2.f * __builtin_amdgcn_rcpf(e + 1.f); }
    if (mode == 4) return __builtin_amdgcn_rcpf(1.f + __expf(-v));
    return v;
}
__device__ __forceinline__ void epilogue(const f32x4 (&acc)[2][2][4][2], const Unit& u, LAS unsigned char* lds, int wr, int wc, int fr, int fq) {
    const LAS Job* jobs = (const LAS Job*)(lds + JOBS_OFF);
    int ldc = rfl(jobs[u.j].ldc), mode = rfl(jobs[u.j].mode);
    const char* Cp = rfl_ptr(jobs[u.j].C);
    int row0 = u.pm * BM + wr * 64 + fr; const int col0 = u.pn * BM + wc * 32 + 4 * fq;
    if (u.part >= 0) { Cp = (const char*)(WSP() + WS_PB) + (size_t)u.part * 256 * D * 4; row0 = wr * 64 + fr; ldc = D; mode = 0; }
    if (mode == 0 || mode >= 5) {
        float* C = (float*)Cp; const float* bias = (const float*)rfl_ptr(jobs[u.j].bias);
#pragma unroll
        for (int ai = 0; ai < 2; ++ai)
#pragma unroll
            for (int m = 0; m < 4; ++m) { float* rowp = C + (size_t)(row0 + ai * HALF + m * 16) * ldc + col0;
#pragma unroll
                for (int bj = 0; bj < 2; ++bj)
#pragma unroll
                    for (int n = 0; n < 2; ++n) { f32x4 v = acc[ai][bj][m][n];
                        if (mode >= 5) { v += *(const f32x4*)(bias + col0 + bj * HALF + n * 16);
#pragma unroll
                            for (int q = 0; q < 4; ++q) { const float sg = __builtin_amdgcn_rcpf(1.f + __expf(-v[q])); v[q] = mode == 5 ? __expf(-0.6065306597126334f * sg) : sg; } }
                        *(f32x4*)(rowp + bj * HALF + n * 16) = v; }
                asm volatile("" ::: "memory"); }
    } else {
        bf16_t* C = (bf16_t*)Cp;
#pragma unroll
        for (int ai = 0; ai < 2; ++ai)
#pragma unroll
            for (int m = 0; m < 4; ++m) { bf16_t* rowp = C + (size_t)(row0 + ai * HALF + m * 16) * ldc + col0;
#pragma unroll
                for (int bj = 0; bj < 2; ++bj)
#pragma unroll
                    for (int n = 0; n < 2; ++n) { const f32x4 v = acc[ai][bj][m][n]; u32x2 w;
                        w.x = pk2(act_fn(v[0], mode), act_fn(v[1], mode)); w.y = pk2(act_fn(v[2], mode), act_fn(v[3], mode));
                        *(u32x2*)(rowp + bj * HALF + n * 16) = w; } }
    }
}

__device__ __forceinline__ void gemm_phase(LAS unsigned char* lds, const int K, const int G, const int c) {
    const int tid = TID(), wid = rfl(tid >> 6), lane = tid & 63, wr = wid >> 2, wc = wid & 3, fr = lane & 15, fq = lane >> 4;
    unsigned voff[2];
#pragma unroll
    for (int i = 0; i < 2; ++i) { int R, C; stage_rc(tid * 16 + i * 8192, R, C); voff[i] = (unsigned)(R * K + C) * 2u; }
    const size_t kstep = (size_t)(BK * 2);
    const size_t hstep = (size_t)HALF * K * 2;
    const unsigned ldsw = (unsigned)wid * 1024u;
    const int aoff = lds_byte(wr * 64 + fr, fq * 8), boff = lds_byte(wc * 32 + fr, fq * 8);
#define PG8_SA(b, h) (((b) * 2 + (h)) * HTB)
#define PG8_SB(b, h) ((4 + (b) * 2 + (h)) * HTB)
#define PG8_STAGE(bufoff, gbase) do { _Pragma("unroll") for (int _i = 0; _i < 2; ++_i) \
        __builtin_amdgcn_global_load_lds((const unsigned*)((const char*)(gbase) + voff[_i]), (LAS unsigned*)(lds + (bufoff) + ldsw + _i * 8192), 16, 0, 0); } while (0)
#define PG8_LDA(dst, b, h) do { _Pragma("unroll") for (int m = 0; m < 4; ++m) _Pragma("unroll") for (int k = 0; k < 2; ++k) dst[m][k] = *(const LAS bf16x8*)(lds + PG8_SA(b, h) + aoff + m * 2048 + k * 1024); } while (0)
#define PG8_LDB(dst, b, h) do { _Pragma("unroll") for (int n = 0; n < 2; ++n) _Pragma("unroll") for (int k = 0; k < 2; ++k) dst[n][k] = *(const LAS bf16x8*)(lds + PG8_SB(b, h) + boff + n * 2048 + k * 1024); } while (0)
#define PG8_MMA(ai, bj, At, Bt) do { __builtin_amdgcn_s_setprio(1); _Pragma("unroll") for (int m = 0; m < 4; ++m) _Pragma("unroll") for (int n = 0; n < 2; ++n) _Pragma("unroll") for (int k = 0; k < 2; ++k) \
        acc[ai][bj][m][n] = __builtin_amdgcn_mfma_f32_16x16x32_bf16(Bt[n][k], At[m][k], acc[ai][bj][m][n], 0, 0, 0); __builtin_amdgcn_s_setprio(0); } while (0)
#define PG8_WAIT_V(n) asm volatile("s_waitcnt vmcnt(" #n ")" ::: "memory")
#define PG8_WAIT_L(n) asm volatile("s_waitcnt lgkmcnt(" #n ")" ::: "memory")
#define PG8_BAR __builtin_amdgcn_s_barrier()
#define PG8_SCHED __builtin_amdgcn_sched_barrier(0)
    Unit cur, nxt; int ui = 0;
    if (!unit_next(lds, 0, G, c, K, cur)) return;
    f32x4 acc[2][2][4][2];
#pragma unroll
    for (int a = 0; a < 2; ++a)
#pragma unroll
        for (int b = 0; b < 2; ++b)
#pragma unroll
            for (int m = 0; m < 4; ++m)
#pragma unroll
                for (int n = 0; n < 2; ++n) acc[a][b][m][n] = (f32x4){0.f, 0.f, 0.f, 0.f};
    bf16x8 At[4][2], B0[2][2], B1[2][2];
    const char* cA = cur.A; const char* cB = cur.B;
    PG8_STAGE(PG8_SB(0, 0), cB); PG8_STAGE(PG8_SB(0, 1), cB + hstep); PG8_STAGE(PG8_SA(0, 0), cA); PG8_STAGE(PG8_SA(0, 1), cA + hstep);
    if (wr == 1) PG8_BAR;
    PG8_WAIT_V(2); PG8_BAR;
    PG8_STAGE(PG8_SB(1, 0), cB + kstep); PG8_STAGE(PG8_SA(1, 0), cA + kstep); PG8_STAGE(PG8_SB(1, 1), cB + hstep + kstep);
    PG8_WAIT_V(6); PG8_BAR;
    for (;;) {
        const bool has_next = unit_next(lds, ui + 1, G, c, K, nxt);
        const char* nA = has_next ? nxt.A : cA; const char* nB = has_next ? nxt.B : cB;
        const int nt = cur.nt;
        for (int t = 0; t < nt; t += 2) {
            const bool last = (t == nt - 2);
            const char* a1 = cA + (size_t)(t + 1) * kstep;
            const char* a2 = last ? nA : cA + (size_t)(t + 2) * kstep; const char* b2 = last ? nB : cB + (size_t)(t + 2) * kstep;
            const char* a3 = a2 + kstep; const char* b3 = b2 + kstep;
            PG8_LDB(B0, 0, 0); PG8_LDB(B1, 0, 1); PG8_SCHED; PG8_LDA(At, 0, 0); PG8_STAGE(PG8_SA(1, 1), a1 + hstep);
            PG8_WAIT_V(8); PG8_WAIT_L(0); PG8_BAR; PG8_MMA(0, 0, At, B0); PG8_MMA(0, 1, At, B1); PG8_BAR; PG8_SCHED;
            PG8_LDA(At, 0, 1); PG8_STAGE(PG8_SB(0, 0), b2); PG8_STAGE(PG8_SB(0, 1), b2 + hstep); PG8_STAGE(PG8_SA(0, 0), a2);
            PG8_WAIT_V(8); PG8_WAIT_L(0); PG8_BAR; PG8_MMA(1, 0, At, B0); PG8_MMA(1, 1, At, B1); PG8_BAR; PG8_SCHED;
            PG8_LDB(B0, 1, 0); PG8_LDB(B1, 1, 1); PG8_SCHED; PG8_LDA(At, 1, 0); PG8_STAGE(PG8_SA(0, 1), a2 + hstep);
            PG8_WAIT_V(8); PG8_WAIT_L(0); PG8_BAR; PG8_MMA(0, 0, At, B0); PG8_MMA(0, 1, At, B1); PG8_BAR; PG8_SCHED;
            PG8_LDA(At, 1, 1); PG8_STAGE(PG8_SB(1, 0), b3); PG8_STAGE(PG8_SB(1, 1), b3 + hstep); PG8_STAGE(PG8_SA(1, 0), a3);
            PG8_WAIT_V(8); PG8_WAIT_L(0); PG8_BAR; PG8_MMA(1, 0, At, B0); PG8_MMA(1, 1, At, B1); PG8_BAR; PG8_SCHED;
        }
        if (wr == 0) PG8_BAR;
        epilogue(acc, cur, lds, wr, wc, fr, fq);
        if (!has_next) break;
#pragma unroll
        for (int a = 0; a < 2; ++a)
#pragma unroll
            for (int b = 0; b < 2; ++b)
#pragma unroll
                for (int m = 0; m < 4; ++m)
#pragma unroll
                    for (int n = 0; n < 2; ++n) acc[a][b][m][n] = (f32x4){0.f, 0.f, 0.f, 0.f};
        cur = nxt; cA = nA; cB = nB; ++ui;
        if (wr == 1) PG8_BAR;
    }
    PG8_WAIT_V(0);
    PG8_BAR;
#undef PG8_SA
#undef PG8_SB
#undef PG8_STAGE
#undef PG8_LDA
#undef PG8_LDB
#undef PG8_MMA
#undef PG8_WAIT_V
#undef PG8_WAIT_L
#undef PG8_BAR
#undef PG8_SCHED
}
}

__device__ __forceinline__ void conv_mat(const float* W, int K, int N, bf16_t* WT, int Kp, int Np, LAS float* scr, int gw, int ngw, int lane) {
    const int nblk = Np / 32, nitems = nblk * (Kp / 64);
    f32x4 nv[8];
#define CONV_LOAD(it_) do { const int kb_ = (it_) / nblk, nb_ = (it_) % nblk; _Pragma("unroll") for (int i = 0; i < 8; ++i) { const int k_ = 64 * kb_ + 8 * i + (lane >> 3), n_ = 32 * nb_ + (lane & 7) * 4; \
        nv[i] = (k_ < K && 32 * nb_ < N) ? *(const f32x4*)(W + (size_t)k_ * N + n_) : (f32x4){0.f, 0.f, 0.f, 0.f}; } } while (0)
    if (gw < nitems) CONV_LOAD(gw);
    for (int item = gw; item < nitems; item += ngw) {
        const int kb = item / nblk, nb = item % nblk, k0 = 64 * kb, n0 = 32 * nb;
#pragma unroll
        for (int i = 0; i < 8; ++i) { const int kk = 8 * i + (lane >> 3), n4 = (lane & 7) * 4; LAS float* d = scr + kk * 33 + n4; d[0] = nv[i][0]; d[1] = nv[i][1]; d[2] = nv[i][2]; d[3] = nv[i][3]; }
        if (item + ngw < nitems) CONV_LOAD(item + ngw);
        asm volatile("s_waitcnt lgkmcnt(0)" ::: "memory");
        const int c = lane & 7;
#pragma unroll
        for (int j = 0; j < 4; ++j) { const int n = (lane >> 3) + 8 * j; const LAS float* s = scr + (8 * c) * 33 + n;
            u32x4 o; o.x = pk2(s[0 * 33], s[1 * 33]); o.y = pk2(s[2 * 33], s[3 * 33]); o.z = pk2(s[4 * 33], s[5 * 33]); o.w = pk2(s[6 * 33], s[7 * 33]);
            *(u32x4*)(WT + (size_t)(n0 + n) * Kp + k0 + 8 * c) = o; }
        asm volatile("s_waitcnt lgkmcnt(0)" ::: "memory");
    }
#undef CONV_LOAD
}

__device__ __forceinline__ void row_load(const float* p, int lane, f32x4 (&v)[8]) {
#pragma unroll
    for (int j = 0; j < 8; ++j) v[j] = *(const f32x4*)(p + 256 * j + 4 * lane);
}
__device__ __forceinline__ void row_load_bf16(const bf16_t* p, int lane, f32x4 (&v)[8]) {
#pragma unroll
    for (int j = 0; j < 8; ++j) { const u32x2 r = *(const u32x2*)(p + 256 * j + 4 * lane);
        v[j][0] = __builtin_bit_cast(float, r.x << 16); v[j][1] = __builtin_bit_cast(float, r.x & 0xffff0000u); v[j][2] = __builtin_bit_cast(float, r.y << 16); v[j][3] = __builtin_bit_cast(float, r.y & 0xffff0000u); }
}
__device__ __forceinline__ float row_rstd(const f32x4 (&v)[8]) {
    float s = 0.f;
#pragma unroll
    for (int j = 0; j < 8; ++j) s += (v[j][0] * v[j][0] + v[j][1] * v[j][1]) + (v[j][2] * v[j][2] + v[j][3] * v[j][3]);
    return rsqrtf(wave_sum(s) * (1.f / D) + 1e-6f);
}
__device__ __forceinline__ void row_store_bf16(bf16_t* p, int lane, const f32x4 (&v)[8]) {
#pragma unroll
    for (int j = 0; j < 8; ++j) { u32x2 w; w.x = pk2(v[j][0], v[j][1]); w.y = pk2(v[j][2], v[j][3]); *(u32x2*)(p + 256 * j + 4 * lane) = w; }
}
__device__ __forceinline__ void presum_sample_rows(bf16_t* MIX, int bid, int tid) {
    if (bid < MS / 4) {
#pragma unroll 1
        for (int r = 0; r < 4; ++r) {
            const size_t off = (size_t)(4 * bid + r) * D + 4 * tid;
            const float* pb = (const float*)(WSP() + WS_PB) + off;
            f32x4 v[KSPLIT];
#pragma unroll
            for (int k = 0; k < KSPLIT; ++k) v[k] = *(const f32x4*)(pb + (size_t)k * 256 * D);
#pragma unroll
            for (int k = 1; k < KSPLIT; ++k) v[0] += v[k];
            { u32x2 w; w.x = pk2(v[0][0], v[0][1]); w.y = pk2(v[0][2], v[0][3]); *(u32x2*)(MIX + (size_t)MP * D + off) = w; }
        }
    }
    __syncthreads();
}
__device__ __forceinline__ void xrow_load(const bf16_t* X, int layer0, int m, int lane, f32x4 (&v)[8]) {
    if (layer0) row_load(m < MP ? IN(0) + (size_t)m * D : IN(1) + (size_t)(m - MP) * D, lane, v);
    else row_load_bf16(X + (size_t)m * D, lane, v);
}

__device__ __forceinline__ void row_pre(const Params& p, int layer) {
    const int tid_ = TID(), lane = tid_ & 63, wave_ = rfl(tid_ >> 6), bid_ = BID(), gw = bid_ * 8 + wave_, ngw = GSZ() * 8;
    unsigned char* ws = WSP();
    const bf16_t* Xold = (const bf16_t*)(ws + ((layer & 1) ? WS_XA : WS_XB));
    bf16_t* Xnew = (bf16_t*)(ws + ((layer & 1) ? WS_XB : WS_XA));
    const bf16_t* DOWN = (const bf16_t*)(ws + WS_MIX);
    if (layer > 0) presum_sample_rows((bf16_t*)(ws + WS_MIX), bid_, tid_);
    const float* gpost = IN(10) + (size_t)(layer - 1) * D;
    const float* gpre = IN(7) + (size_t)layer * D;
    const bool odd = layer & 1;
    const int o = layer >> 1;
    const int nit = (MP / 4 - gw + ngw - 1) / ngw;
    for (int it_ = 0; it_ <= nit; ++it_) {
        int item = gw + it_ * ngw;
        if (it_ == nit) { if (wave_ != 0 || bid_ >= MS / 4) break; item = MP / 4 + bid_; }
        const int m0 = item * 4;
        const int t0 = m0 < MP ? (m0 & (SEQ - 1)) : ((m0 - MP) & (DSEQ - 1));
        const int b = m0 < MP ? (m0 >> 12) : ((m0 - MP) >> 3);
        const int Lseq = m0 < MP ? SEQ : DSEQ;
        f32x4 hp[8];
        const int rstart = (odd && t0 > 0) ? -1 : 0;
        if (odd && t0 == 0) {
            if (m0 < MP) {
#pragma unroll
                for (int j = 0; j < 8; ++j) hp[j] = (f32x4){0.f, 0.f, 0.f, 0.f};
            } else row_load(IN(6) + ((size_t)o * 32 + b) * D, lane, hp);
        }
        for (int r = rstart; r < 4; ++r) {
            const int m = m0 + r;
            f32x4 x[8];
            xrow_load(Xold, layer == 0, m, lane, x);
            if (layer > 0) {
                f32x4 dn[8]; row_load_bf16(DOWN + (size_t)m * D, lane, dn);
                const float rs = row_rstd(dn);
#pragma unroll
                for (int j = 0; j < 8; ++j) { const f32x4 g = *(const f32x4*)(gpost + 256 * j + 4 * lane); x[j] += dn[j] * rs * g; }
                if (r >= 0) {
#pragma unroll
                    for (int j = 0; j < 8; ++j) { if (layer == 4) *(f32x4*)(OUTP() + (size_t)m * D + 256 * j + 4 * lane) = x[j];
                        else { u32x2 w; w.x = pk2(x[j][0], x[j][1]); w.y = pk2(x[j][2], x[j][3]); *(u32x2*)(Xnew + (size_t)m * D + 256 * j + 4 * lane) = w; } }
                }
            }
            if (layer == 4) continue;
            const float rs = row_rstd(x);
#pragma unroll
            for (int j = 0; j < 8; ++j) { const f32x4 g = *(const f32x4*)(gpre + 256 * j + 4 * lane); x[j] = x[j] * rs * g; }
            if (!odd) { row_store_bf16((bf16_t*)(ws + WS_HB) + (size_t)m * D, lane, x); continue; }
            if (r >= 0) {
                const float* mu = IN(17) + (size_t)o * 6 * D;
#pragma unroll 1
                for (int i = 0; i < 6; ++i) {
                    bf16_t* dst = (bf16_t*)(ws + WS_XMIX) + (size_t)i * M * D + (size_t)m * D;
#pragma unroll
                    for (int j = 0; j < 8; ++j) { const f32x4 mv = *(const f32x4*)(mu + (size_t)i * D + 256 * j + 4 * lane); const f32x4 y = x[j] + (hp[j] - x[j]) * mv;
                        u32x2 w; w.x = pk2(y[0], y[1]); w.y = pk2(y[2], y[3]); *(u32x2*)(dst + 256 * j + 4 * lane) = w; }
                }
                if (t0 + r == Lseq - 1) {
                    float* so = OUTP() + (m0 < MP ? OFF_SP + ((size_t)o * 2 + b) * D : OFF_SS + ((size_t)o * 32 + b) * D);
#pragma unroll
                    for (int j = 0; j < 8; ++j) *(f32x4*)(so + 256 * j + 4 * lane) = x[j];
                }
            }
#pragma unroll
            for (int j = 0; j < 8; ++j) hp[j] = x[j];
        }
    }
}

__device__ __forceinline__ void row_post1(const Params& p, int layer) {
    const int tid_ = TID(), lane = tid_ & 63, wave_ = rfl(tid_ >> 6), bid_ = BID(), gw = bid_ * 8 + wave_, ngw = GSZ() * 8;
    unsigned char* ws = WSP();
    bf16_t* X = (bf16_t*)(ws + ((layer & 1) ? WS_XB : WS_XA));
    const bf16_t* MIX = (const bf16_t*)(ws + WS_MIX);
    const float* g1 = IN(8) + (size_t)layer * D; const float* g2 = IN(9) + (size_t)layer * D;
    presum_sample_rows((bf16_t*)(ws + WS_MIX), bid_, tid_);
    const int nit = (MP - gw + ngw - 1) / ngw;
    for (int it_ = 0; it_ <= nit; ++it_) {
        int m = gw + it_ * ngw;
        if (it_ == nit) { if (wave_ >= 4 || bid_ >= MS / 4) break; m = MP + 4 * bid_ + wave_; }
        f32x4 x[8], mx[8];
        xrow_load(X, layer == 0, m, lane, x);
        row_load_bf16(MIX + (size_t)m * D, lane, mx);
        const float rs = row_rstd(mx);
#pragma unroll
        for (int j = 0; j < 8; ++j) { const f32x4 g = *(const f32x4*)(g1 + 256 * j + 4 * lane); x[j] += mx[j] * rs * g; u32x2 w; w.x = pk2(x[j][0], x[j][1]); w.y = pk2(x[j][2], x[j][3]); *(u32x2*)(X + (size_t)m * D + 256 * j + 4 * lane) = w; }
        const float rs2 = row_rstd(x);
#pragma unroll
        for (int j = 0; j < 8; ++j) { const f32x4 g = *(const f32x4*)(g2 + 256 * j + 4 * lane); x[j] = x[j] * rs2 * g; }
        row_store_bf16((bf16_t*)(ws + WS_HB) + (size_t)m * D, lane, x);
    }
}

__device__ __forceinline__ void row_hg(const Params& p, int e) {
    const int tid_ = TID(), lane = tid_ & 63, gw = BID() * 8 + rfl(tid_ >> 6), ngw = GSZ() * 8;
    unsigned char* ws = WSP();
    const float* O0 = (const float*)(ws + WS_OPART); const float* O1 = O0 + (size_t)M * 1024;
    const float* PROJ = (const float*)(ws + WS_PROJ);
    const float* g = IN(14) + (size_t)e * 1024;
    bf16_t* MA = (bf16_t*)(ws + WS_MA);
    for (int m = gw; m < M; m += ngw) {
        f32x4 v[4]; float s = 0.f;
#pragma unroll
        for (int j = 0; j < 4; ++j) { v[j] = *(const f32x4*)(O0 + (size_t)m * 1024 + 256 * j + 4 * lane); if (m >= MP) v[j] += *(const f32x4*)(O1 + (size_t)m * 1024 + 256 * j + 4 * lane);
            s += (v[j][0] * v[j][0] + v[j][1] * v[j][1]) + (v[j][2] * v[j][2] + v[j][3] * v[j][3]); }
        const float rs = rsqrtf(wave_sum(s) * (1.f / 1024.f) + 1e-6f);
#pragma unroll
        for (int j = 0; j < 4; ++j) { const f32x4 gg = *(const f32x4*)(g + 256 * j + 4 * lane); const f32x4 ga = *(const f32x4*)(PROJ + (size_t)m * IN_EVEN + 3072 + 256 * j + 4 * lane);
            f32x4 y = v[j] * rs * gg;
#pragma unroll
            for (int q = 0; q < 4; ++q) y[q] *= ga[q] * sigmoidf_(ga[q]);
            u32x2 w; w.x = pk2(y[0], y[1]); w.y = pk2(y[2], y[3]); *(u32x2*)(MA + (size_t)m * D + 256 * j + 4 * lane) = w; }
    }
}

__device__ __forceinline__ void row_gn(const Params& p, int layer) {
    const int tid_ = TID(), lane = tid_ & 63, gw = BID() * 8 + rfl(tid_ >> 6), ngw = GSZ() * 8;
    unsigned char* ws = WSP(); const int o = layer >> 1;
    const float* Y = (const float*)(ws + WS_MIX);
    const float* BONUS = (const float*)(ws + WS_XA);
    const bf16_t* G2O = (const bf16_t*)(ws + WS_HB);
    const float* lg = IN(36) + (size_t)o * D; const float* lb = IN(37) + (size_t)o * D;
    bf16_t* MA = (bf16_t*)(ws + WS_MA);
    for (int m = gw; m < M; m += ngw) {
#pragma unroll
        for (int j = 0; j < 8; ++j) {
            const int c = 256 * j + 4 * lane;
            const f32x4 y = *(const f32x4*)(Y + (size_t)m * D + c);
            const float mean = red16((y[0] + y[1]) + (y[2] + y[3])) * (1.f / 64.f);
            const f32x4 d = y - mean;
            const float var = red16((d[0] * d[0] + d[1] * d[1]) + (d[2] * d[2] + d[3] * d[3])) * (1.f / 64.f);
            const float rs = rsqrtf(var + 64e-5f);
            const f32x4 bo = *(const f32x4*)(BONUS + (size_t)m * D + c);
            const u32x2 gr = *(const u32x2*)(G2O + (size_t)m * D + c);
            const f32x4 gg = *(const f32x4*)(lg + c), bb = *(const f32x4*)(lb + c);
            f32x4 gt; gt[0] = __builtin_bit_cast(float, gr.x << 16); gt[1] = __builtin_bit_cast(float, gr.x & 0xffff0000u); gt[2] = __builtin_bit_cast(float, gr.y << 16); gt[3] = __builtin_bit_cast(float, gr.y & 0xffff0000u);
            const f32x4 r = (d * rs * gg + bb + bo) * gt;
            u32x2 w; w.x = pk2(r[0], r[1]); w.y = pk2(r[2], r[3]); *(u32x2*)(MA + (size_t)m * D + c) = w;
        }
    }
}

constexpr int REC = 336, CH = 32;
constexpr int YP_OFF = 2 * CH * REC;
constexpr int NITEMS_SCAN = 256 + 4096;
typedef float f32x2 __attribute__((ext_vector_type(2)));
struct ScanDesc { int b, h, kh, row0, tok0, nv, samp, ok; };
template <bool RW> __device__ __forceinline__ ScanDesc scan_desc(int it, int c) {
    ScanDesc d; d.ok = it < NITEMS_SCAN; d.samp = it >= 256; const int ii = d.samp ? it - 256 : it; d.kh = 0;
    if (RW) { const int chain = ii >> 2; d.row0 = (ii & 3) * 16; d.b = chain >> 5; d.h = chain & 31; }
    else { const int chain = ii >> 3; d.row0 = (ii & 7) * 16; d.b = chain >> 4; d.h = (chain >> 1) & 7; d.kh = chain & 1; }
    const int L = d.samp ? DSEQ : SEQ; d.tok0 = (d.samp ? MP + d.b * DSEQ : d.b * SEQ) + c * CH; d.nv = (L - c * CH) < CH ? (L - c * CH) : CH;
    return d;
}
__device__ __forceinline__ void scan_adv(int& it, int& c, int gsz) { ++c; if (c >= (it < 256 ? SEQ / CH : 1)) { c = 0; it += gsz; } }
struct ScanRec { f32x4 w, k, r, kk, kka; float v; };
#define LO2(x) __builtin_shufflevector(x, x, 0, 1)
#define HI2(x) __builtin_shufflevector(x, x, 2, 3)

template <bool RW>
__device__ __forceinline__ void scan_phase(const Params& p, LAS unsigned char* lds8, const int li  , const int it0 = 0) {
    unsigned char* ws = WSP();
    LAS float* lds = (LAS float*)lds8;
    const int tid = TID(), wave = rfl(tid >> 6), lane = tid & 63, bid = BID(), gsz = GSZ();
    const bool consumer = wave < 4;
    const float* R_ = (const float*)(ws + WS_R); const float* K_ = (const float*)(ws + WS_K);
    const float* V_ = (const float*)(ws + (li == 0 ? WS_VF : WS_V3)); const float* VF_ = (const float*)(ws + WS_VF);
    const float* W2O = (const float*)(ws + WS_W2O); const float* A2O = (const float*)(ws + WS_A2O); const float* V2O = (const float*)(ws + WS_V2O);
    float* Y_ = (float*)(ws + WS_MIX); float* BONUS = (float*)(ws + WS_XA);
    const float* PROJ = (const float*)(ws + WS_PROJ); float* OPART = (float*)(ws + WS_OPART);
    const int ptid = tid & 255, tt = ptid >> 4, c4 = ptid & 15;
    f32x4 raw[2][7], cp[6];
    ScanDesc pd; pd.ok = 0;
    int lit = it0 + bid, lc = 0;
    const int rg = lane >> 4, cl = lane & 15, crow = (wave & 3) * 4 + rg;
    f32x2 s01 = (f32x2){0.f, 0.f}, s23 = s01; f32x4 snext = (f32x4){0.f, 0.f, 0.f, 0.f};
#define P_LOAD() do { pd = scan_desc<RW>(lit, lc); if (pd.ok) { \
        if (RW) { const int c_ = pd.h * 64 + 4 * c4; \
            cp[3] = *(const f32x4*)(IN(33) + (size_t)li * D + c_); cp[4] = *(const f32x4*)(IN(34) + (size_t)li * D + c_); cp[5] = *(const f32x4*)(IN(35) + (size_t)li * D + c_); \
        } else if (li) { const int c_ = pd.h * 128 + pd.kh * 64 + 4 * c4; cp[0] = *(const f32x4*)(IN(13) + c_); cp[1] = *(const f32x4*)(IN(13) + 1024 + c_); } \
        _Pragma("unroll") for (int pr = 0; pr < 2; ++pr) { const int tl_ = tt + 16 * pr; if (tl_ < pd.nv) { const size_t m_ = (size_t)(pd.tok0 + tl_); \
            if (RW) { const size_t o_ = m_ * D + pd.h * 64 + 4 * c4; raw[pr][0] = *(const f32x4*)(R_ + o_); raw[pr][1] = *(const f32x4*)(K_ + o_); raw[pr][2] = *(const f32x4*)(V_ + o_); \
                raw[pr][3] = *(const f32x4*)(W2O + o_); raw[pr][4] = *(const f32x4*)(A2O + o_); if (li) { raw[pr][5] = *(const f32x4*)(V2O + o_); raw[pr][6] = *(const f32x4*)(VF_ + o_); } } \
            else { const size_t o_ = m_ * IN_EVEN + pd.h * 128 + pd.kh * 64 + 4 * c4; raw[pr][0] = *(const f32x4*)(PROJ + o_); raw[pr][1] = *(const f32x4*)(PROJ + 1024 + o_); \
                if (c4 < 4) raw[pr][2] = *(const f32x4*)(PROJ + m_ * IN_EVEN + 2048 + pd.h * 128 + pd.row0 + 4 * c4); } } } } \
        scan_adv(lit, lc, gsz); } while (0)
#define P_PUT(buf) do { if (pd.ok) { _Pragma("unroll") for (int pr = 0; pr < 2; ++pr) { const int tl_ = tt + 16 * pr; if (tl_ < pd.nv) { LAS float* rec_ = (buf) + tl_ * REC + 4 * c4; \
        if (RW) { f32x4 dec, a, v = raw[pr][2], kk, km, kka; float ss = 0.f, rk = 0.f; \
            _Pragma("unroll") for (int q_ = 0; q_ < 4; ++q_) { dec[q_] = raw[pr][3][q_]; \
                a[q_] = raw[pr][4][q_]; if (li) v[q_] = raw[pr][2][q_] + (raw[pr][6][q_] - raw[pr][2][q_]) * raw[pr][5][q_]; \
                kk[q_] = raw[pr][1][q_] * cp[3][q_]; ss += kk[q_] * kk[q_]; km[q_] = raw[pr][1][q_] * (1.f + (a[q_] - 1.f) * cp[4][q_]); rk += raw[pr][0][q_] * km[q_] * cp[5][q_]; } \
            ss = red16(ss); rk = red16(rk); const float inv = rsqrtf(fmaxf(ss, 1e-24f)); \
            _Pragma("unroll") for (int q_ = 0; q_ < 4; ++q_) { kk[q_] *= inv; kka[q_] = kk[q_] * a[q_]; } \
            *(LAS f32x4*)(rec_) = dec; *(LAS f32x4*)(rec_ + 64) = km; *(LAS f32x4*)(rec_ + 128) = raw[pr][0]; *(LAS f32x4*)(rec_ + 192) = kk; *(LAS f32x4*)(rec_ + 256) = kka; \
            if ((c4 >> 2) == (pd.row0 >> 4)) { *(LAS f32x4*)((buf) + tl_ * REC + 320 + 4 * (c4 & 3)) = v; *(f32x4*)(BONUS + (size_t)(pd.tok0 + tl_) * D + pd.h * 64 + 4 * c4) = v * rk; } } \
        else { f32x4 f, kk, qq; \
            _Pragma("unroll") for (int q_ = 0; q_ < 4; ++q_) { const float plb = li ? sigmoidf_(cp[1][q_] - cp[0][q_]) : 0.f; \
                const float sg = sigmoidf_(raw[pr][1][q_]); f[q_] = plb + (1.f - plb) * sg; kk[q_] = (1.f - plb) * (1.f - sg); qq[q_] = raw[pr][0][q_] * sigmoidf_(raw[pr][0][q_]) * 0.08838834764831845f; } \
            *(LAS f32x4*)(rec_) = f; *(LAS f32x4*)(rec_ + 64) = kk; *(LAS f32x4*)(rec_ + 128) = qq; \
            if (c4 < 4) *(LAS f32x4*)((buf) + tl_ * REC + 320 + 4 * c4) = raw[pr][2]; } } } } } while (0)
#define P_REDUCE(yd, par) do { const LAS float* yp_ = lds + YP_OFF + (par) * (CH * 256); \
        _Pragma("unroll") for (int k_ = 0; k_ < 2; ++k_) { const int idx = ptid + 256 * k_, t_ = idx >> 4, row = idx & 15; \
            if (t_ < (yd).nv) { const LAS f32x4* s4 = (const LAS f32x4*)(yp_ + idx * 16); const f32x4 a_ = (s4[0] + s4[1]) + (s4[2] + s4[3]); const float y_ = (a_[0] + a_[1]) + (a_[2] + a_[3]); \
                if (RW) Y_[(size_t)((yd).tok0 + t_) * D + (yd).h * 64 + (yd).row0 + row] = y_; \
                else OPART[(size_t)(yd).kh * M * 1024 + (size_t)((yd).tok0 + t_) * 1024 + (yd).h * 128 + (yd).row0 + row] = y_; } } } while (0)
#define C_S0(dd, dst) do { if (RW) dst = *(const f32x4*)(IN(5) + ((((size_t)li * 32 + (dd).b) * 32 + (dd).h) * 64 + (dd).row0 + crow) * 64 + 4 * cl); \
        else { const float* S0_ = IN(2) + (((size_t)li * 32 + (dd).b) * 8 + (dd).h) * 16384 + (size_t)((dd).kh * 64 + 4 * cl) * 128 + (dd).row0 + crow; \
            dst[0] = S0_[0]; dst[1] = S0_[128]; dst[2] = S0_[256]; dst[3] = S0_[384]; } } while (0)
    __syncthreads();
    int cit = it0 + bid, cc = 0;
    if (!consumer) { P_LOAD(); P_PUT(lds); P_LOAD(); }
    else { const ScanDesc d0 = scan_desc<RW>(cit, cc); if (d0.ok && d0.samp) C_S0(d0, snext); }
    __syncthreads();
    ScanDesc prevd; prevd.ok = 0; prevd.nv = 0; prevd.tok0 = 0; prevd.h = 0; prevd.kh = 0; prevd.row0 = 0;
    int q = 0;
    for (;; ++q) {
        const ScanDesc cd = scan_desc<RW>(cit, cc);
        if (!cd.ok) break;
        if (consumer) {
            int nit = cit, nc = cc; scan_adv(nit, nc, gsz); const ScanDesc nd = scan_desc<RW>(nit, nc);
            if (cc == 0) { if (cd.samp) { s01 = LO2(snext); s23 = HI2(snext); } else { s01 = (f32x2){0.f, 0.f}; s23 = s01; } }
            if (nd.ok && nc == 0 && nd.samp) C_S0(nd, snext);
            const LAS float* cur = lds + (q & 1) * (CH * REC);
            LAS float* yp = lds + YP_OFF + (q & 1) * (CH * 256) + crow * 16 + cl;
#define C_LD(R, t) do { const LAS float* rec_ = cur + (t) * REC; R.w = *(const LAS f32x4*)(rec_ + 4 * cl); R.k = *(const LAS f32x4*)(rec_ + 64 + 4 * cl); R.r = *(const LAS f32x4*)(rec_ + 128 + 4 * cl); \
                if (RW) { R.kk = *(const LAS f32x4*)(rec_ + 192 + 4 * cl); R.kka = *(const LAS f32x4*)(rec_ + 256 + 4 * cl); } R.v = rec_[320 + crow]; } while (0)
#define SB_ __builtin_amdgcn_sched_barrier(0)
#define C_STEP(R, P, t) do { \
                if (RW) { f32x2 pp = s01 * LO2(R.kk); pp = s23 * HI2(R.kk) + pp; float x_ = pp.x + pp.y; SB_; \
                      \
                    f32x2 qq_ = s01 * LO2(P.r); SB_; x_ += dppf<0xB1>(x_); SB_; f32x2 t01 = s01 * LO2(R.w); qq_ = s23 * HI2(P.r) + qq_; SB_; \
                    x_ += dppf<0x4E>(x_); SB_; f32x2 t23 = s23 * HI2(R.w); const float yprev_ = qq_.x + qq_.y; SB_; \
                    x_ += dppf<0x141>(x_); SB_; t01 = LO2(R.k) * R.v + t01; if ((t) > 0) yp[((t) - 1) * 256] = yprev_; SB_; \
                    x_ += dppf<0x140>(x_); SB_; t23 = HI2(R.k) * R.v + t23; SB_; \
                    const float sa = -x_; s01 = LO2(R.kka) * sa + t01; s23 = HI2(R.kka) * sa + t23; } \
                else { s01 = s01 * LO2(R.w) + LO2(R.k) * R.v; s23 = s23 * HI2(R.w) + HI2(R.k) * R.v; \
                    f32x2 qq_ = s01 * LO2(R.r); qq_ = s23 * HI2(R.r) + qq_; yp[(t) * 256] = qq_.x + qq_.y; } } while (0)
            ScanRec A, B, C, E;
            C_LD(A, 0); C_LD(B, 1);
#define C_8(t) do { C_LD(C, (t) + 2); C_STEP(A, E, (t)); C_LD(E, (t) + 3); C_STEP(B, A, (t) + 1); C_LD(A, (t) + 4); C_STEP(C, B, (t) + 2); C_LD(B, (t) + 5); C_STEP(E, C, (t) + 3); \
                    C_LD(C, (t) + 6); C_STEP(A, E, (t) + 4); C_LD(E, (t) + 7); C_STEP(B, A, (t) + 5); C_LD(A, (t) + 8); C_STEP(C, B, (t) + 6); C_LD(B, (t) + 9); C_STEP(E, C, (t) + 7); } while (0)
            C_8(0);
            if (cd.nv > 8) { C_8(8); C_8(16); C_8(24); }
#undef C_8
            if (RW) { f32x2 qq_ = s01 * LO2(E.r); qq_ = s23 * HI2(E.r) + qq_; yp[(cd.nv - 1) * 256] = qq_.x + qq_.y; }
#undef C_LD
#undef C_STEP
#undef SB_
            if (cc == (cit < 256 ? SEQ / CH - 1 : 0)) {
                const f32x4 s = (f32x4){s01.x, s01.y, s23.x, s23.y};
                if (RW) { float* So = OUTP() + (cd.samp ? OFF_RS + ((((size_t)li * 32 + cd.b) * 32 + cd.h) * 64 + cd.row0 + crow) * 64 : OFF_RP + ((((size_t)li * 2 + cd.b) * 32 + cd.h) * 64 + cd.row0 + crow) * 64) + 4 * cl;
                    *(f32x4*)So = s; }
                else { float* So = OUTP() + (cd.samp ? OFF_HS + (((size_t)li * 32 + cd.b) * 8 + cd.h) * 16384 : OFF_HP + (((size_t)li * 2 + cd.b) * 8 + cd.h) * 16384) + (size_t)(cd.kh * 64 + 4 * cl) * 128 + cd.row0 + crow;
                    So[0] = s[0]; So[128] = s[1]; So[256] = s[2]; So[384] = s[3]; }
            }
        } else {
            LAS float* nb = lds + ((q + 1) & 1) * (CH * REC);
            P_PUT(nb);
            P_LOAD();
            if (prevd.ok) P_REDUCE(prevd, (q + 1) & 1);
        }
        prevd = cd; scan_adv(cit, cc, gsz);
        __syncthreads();
    }
    if (!consumer && prevd.ok) P_REDUCE(prevd, (q + 1) & 1);
    __syncthreads();
#undef P_LOAD
#undef P_PUT
#undef P_REDUCE
#undef C_S0
}

constexpr int NHI = 2 * 8 * 64;
constexpr size_t WS_LBUF = WS_T + 256 * MiB, WS_DTOT = WS_T + 320 * MiB;
constexpr int RS128 = 136, RS64 = 72;
typedef short s16x4 __attribute__((ext_vector_type(4)));
__device__ __forceinline__ unsigned short bf1(float f) { return (unsigned short)(pk2(f, 0.f) & 0xffffu); }
#define HG_GATES(WANT_Q) \
    float gl[16], kg[16], qg[16]; \
    { float fqv[16], qav[16]; const float* src = PROJ + (size_t)(m0 + 16 * J) * IN_EVEN + h * 128 + k; \
      _Pragma("unroll") for (int jj = 0; jj < 16; ++jj) { fqv[jj] = src[(size_t)jj * IN_EVEN + 1024]; if (WANT_Q) qav[jj] = src[(size_t)jj * IN_EVEN]; } \
      float run = 0.f; \
      _Pragma("unroll") for (int jj = 0; jj < 16; ++jj) { const float sg = sigmoidf_(fqv[jj]); const float f = lb + (1.f - lb) * sg; run += __logf(f); gl[jj] = run; kg[jj] = (1.f - lb) * (1.f - sg); \
          if (WANT_Q) qg[jj] = qav[jj] * sigmoidf_(qav[jj]) * 0.08838834764831845f; else qg[jj] = 0.f; } \
      tots[J * 128 + k] = run; }

__device__ __forceinline__ void hgrn_h1(LAS unsigned char* lds8, const int e) {
    unsigned char* ws = WSP();
    const float* PROJ = (const float*)(ws + WS_PROJ);
    float* LBUF = (float*)(ws + WS_LBUF); float* DTOT = (float*)(ws + WS_DTOT);
    LAS unsigned short* KhT = (LAS unsigned short*)lds8;
    LAS unsigned short* VT = KhT + 128 * RS64;
    LAS float* tots = (LAS float*)(VT + 128 * RS64);
    const int tid = TID(), bid = BID(), gsz = GSZ(), lane = tid & 63, wave = rfl(tid >> 6);
    const int k = tid & 127, J = tid >> 7;
    for (int item = bid; item < NHI; item += gsz) {
        const int b = item >> 9, h = (item >> 6) & 7, c = item & 63, m0 = b * SEQ + c * 64;
        const float lb = e ? sigmoidf_(IN(13)[1024 + h * 128 + k] - IN(13)[h * 128 + k]) : 0.f;
        __syncthreads();
        HG_GATES(false)
        { const float* vs = PROJ + (size_t)(m0 + 16 * J) * IN_EVEN + 2048 + h * 128 + k;
#pragma unroll
          for (int jj = 0; jj < 16; ++jj) VT[k * RS64 + 16 * J + jj] = bf1(vs[(size_t)jj * IN_EVEN]); }
        __syncthreads();
        { const float t0 = tots[k], t1 = tots[128 + k], t2 = tots[256 + k], t3 = tots[384 + k];
          const float gs = J == 0 ? 0.f : (J == 1 ? t0 : (J == 2 ? t0 + t1 : t0 + t1 + t2)), glast = (t0 + t1) + (t2 + t3);
#pragma unroll
          for (int jj = 0; jj < 16; ++jj) KhT[k * RS64 + 16 * J + jj] = bf1(kg[jj] * __expf(glast - gs - gl[jj]));
          if (J == 0) DTOT[(size_t)item * 128 + k] = __expf(glast); }
        __syncthreads();
        f32x4 acc[8];
#pragma unroll
        for (int nt = 0; nt < 8; ++nt) acc[nt] = (f32x4){0.f, 0.f, 0.f, 0.f};
        const int fr = lane & 15, fq = lane >> 4;
#pragma unroll
        for (int s = 0; s < 2; ++s) {
            const bf16x8 a = *(const LAS bf16x8*)(KhT + (16 * wave + fr) * RS64 + 32 * s + 8 * fq);
#pragma unroll
            for (int nt = 0; nt < 8; ++nt) { const bf16x8 bb = *(const LAS bf16x8*)(VT + (16 * nt + fr) * RS64 + 32 * s + 8 * fq);
                acc[nt] = __builtin_amdgcn_mfma_f32_16x16x32_bf16(a, bb, acc[nt], 0, 0, 0); }
        }
        float* Lo = LBUF + (size_t)item * 16384 + (size_t)(16 * wave + 4 * fq) * 128 + fr;
#pragma unroll
        for (int nt = 0; nt < 8; ++nt)
#pragma unroll
            for (int r = 0; r < 4; ++r) Lo[r * 128 + 16 * nt] = acc[nt][r];
    }
    __syncthreads();
}

__device__ __forceinline__ void hgrn_h2(const int e) {
    unsigned char* ws = WSP();
    float* LBUF = (float*)(ws + WS_LBUF); const float* DTOT = (const float*)(ws + WS_DTOT);
    const int tid = TID(), bid = BID(), gsz = GSZ();
    typedef float f32x2h __attribute__((ext_vector_type(2)));
    for (int gid = bid * 512 + tid; gid < 16 * 128 * 64; gid += gsz * 512) {
        const int bh = gid >> 13, k = (gid >> 6) & 127, v2 = (gid & 63) * 2;
        f32x2h S = (f32x2h){0.f, 0.f};
        float* ptr = LBUF + (size_t)bh * 64 * 16384 + (size_t)k * 128 + v2; const float* dp = DTOT + (size_t)bh * 64 * 128 + k;
#pragma unroll 8
        for (int c = 0; c < 64; ++c) { const f32x2h t = *(const f32x2h*)(ptr + (size_t)c * 16384); const float d = dp[c * 128]; *(f32x2h*)(ptr + (size_t)c * 16384) = S; S = S * d + t; }
        *(f32x2h*)(OUTP() + OFF_HP + ((size_t)e * 16 + bh) * 16384 + (size_t)k * 128 + v2) = S;
    }
}

__device__ __forceinline__ void hgrn_h3(LAS unsigned char* lds8, const int e) {
    unsigned char* ws = WSP();
    const float* PROJ = (const float*)(ws + WS_PROJ);
    const float* LBUF = (const float*)(ws + WS_LBUF); float* O0 = (float*)(ws + WS_OPART);
    LAS unsigned short* Qt = (LAS unsigned short*)lds8;
    LAS unsigned short* Qb = Qt + 64 * RS128;
    LAS unsigned short* KT = Qb + 64 * RS128;
    LAS unsigned short* VT = KT + 160 * RS128;
    LAS unsigned short* ST = VT + 128 * RS64;
    LAS float* tots = (LAS float*)(ST + 128 * RS128);
    const int tid = TID(), bid = BID(), gsz = GSZ(), lane = tid & 63, wave = rfl(tid >> 6);
    const int k = tid & 127, J = tid >> 7;
    for (int item = bid; item < NHI; item += gsz) {
        const int b = item >> 9, h = (item >> 6) & 7, c = item & 63, m0 = b * SEQ + c * 64;
        const float lb = e ? sigmoidf_(IN(13)[1024 + h * 128 + k] - IN(13)[h * 128 + k]) : 0.f;
        __syncthreads();
        HG_GATES(true)
        { const float* vs = PROJ + (size_t)(m0 + 16 * J) * IN_EVEN + 2048 + h * 128 + k;
#pragma unroll
          for (int jj = 0; jj < 16; ++jj) VT[k * RS64 + 16 * J + jj] = bf1(vs[(size_t)jj * IN_EVEN]); }
        { const float* Sp = LBUF + (size_t)item * 16384;
#pragma unroll
          for (int i = 0; i < 8; ++i) { const int idx = tid + 512 * i, kk_ = idx >> 5, v4 = (idx & 31) * 4; const f32x4 sv = *(const f32x4*)(Sp + kk_ * 128 + v4);
              ST[(v4 + 0) * RS128 + kk_] = bf1(sv[0]); ST[(v4 + 1) * RS128 + kk_] = bf1(sv[1]); ST[(v4 + 2) * RS128 + kk_] = bf1(sv[2]); ST[(v4 + 3) * RS128 + kk_] = bf1(sv[3]); } }
        __syncthreads();
        { const float t0 = tots[k], t1 = tots[128 + k], t2 = tots[256 + k];
          const float gsI[4] = {0.f, t0, t0 + t1, t0 + t1 + t2};
          const float gs = J == 0 ? gsI[0] : (J == 1 ? gsI[1] : (J == 2 ? gsI[2] : gsI[3]));
#pragma unroll
          for (int jj = 0; jj < 16; ++jj) { const int i = 16 * J + jj;
              Qt[i * RS128 + k] = bf1(qg[jj] * __expf(gl[jj])); Qb[i * RS128 + k] = bf1(qg[jj] * __expf(gs + gl[jj]));
#pragma unroll
              for (int I = 0; I < 4; ++I) if (I >= J) { const int rb = 8 * I * (I + 1);
                  KT[(rb + i) * RS128 + k] = bf1(kg[jj] * __expf(fminf(gsI[I] - gs - gl[jj], 80.f))); } } }
        __syncthreads();
        const int fr = lane & 15, fq = lane >> 4;
        f32x4 acc[4];
#pragma unroll
        for (int I = 0; I < 4; ++I) acc[I] = (f32x4){0.f, 0.f, 0.f, 0.f};
#pragma unroll
        for (int ks = 0; ks < 4; ++ks) { const bf16x8 a = *(const LAS bf16x8*)(ST + (16 * wave + fr) * RS128 + 32 * ks + 8 * fq);
#pragma unroll
            for (int I = 0; I < 4; ++I) { const bf16x8 bb = *(const LAS bf16x8*)(Qb + (16 * I + fr) * RS128 + 32 * ks + 8 * fq);
                acc[I] = __builtin_amdgcn_mfma_f32_16x16x32_bf16(a, bb, acc[I], 0, 0, 0); } }
#pragma unroll
        for (int I = 0; I < 4; ++I) {
            const int rb = 8 * I * (I + 1);
            f32x4 P[4];
#pragma unroll
            for (int Jt = 0; Jt < 4; ++Jt) { P[Jt] = (f32x4){0.f, 0.f, 0.f, 0.f};
                if (Jt <= I) {
#pragma unroll
                    for (int ks = 0; ks < 4; ++ks) { const bf16x8 a = *(const LAS bf16x8*)(KT + (rb + 16 * Jt + fr) * RS128 + 32 * ks + 8 * fq);
                        const bf16x8 bb = *(const LAS bf16x8*)(Qt + (16 * I + fr) * RS128 + 32 * ks + 8 * fq);
                        P[Jt] = __builtin_amdgcn_mfma_f32_16x16x32_bf16(a, bb, P[Jt], 0, 0, 0); }
                    if (Jt == I) {
#pragma unroll
                        for (int r = 0; r < 4; ++r) P[Jt][r] = (4 * fq + r <= fr) ? P[Jt][r] : 0.f; }
                } }
#pragma unroll
            for (int s = 0; s < 2; ++s) if (2 * s <= I) {
                u32x4 pw; pw.x = pk2(P[2 * s][0], P[2 * s][1]); pw.y = pk2(P[2 * s][2], P[2 * s][3]); pw.z = pk2(P[2 * s + 1][0], P[2 * s + 1][1]); pw.w = pk2(P[2 * s + 1][2], P[2 * s + 1][3]);
                const s16x4 v0 = *(const LAS s16x4*)(VT + (16 * wave + fr) * RS64 + 32 * s + 4 * fq), v1 = *(const LAS s16x4*)(VT + (16 * wave + fr) * RS64 + 32 * s + 16 + 4 * fq);
                const bf16x8 a = (bf16x8){v0[0], v0[1], v0[2], v0[3], v1[0], v1[1], v1[2], v1[3]};
                acc[I] = __builtin_amdgcn_mfma_f32_16x16x32_bf16(a, __builtin_bit_cast(bf16x8, pw), acc[I], 0, 0, 0); }
        }
#pragma unroll
        for (int I = 0; I < 4; ++I) *(f32x4*)(O0 + (size_t)(m0 + 16 * I + fr) * 1024 + h * 128 + 16 * wave + 4 * fq) = acc[I];
    }
    __syncthreads();
}

constexpr int KROWS = 160, SW_KS = 72, SW_VS = 168;
__device__ __forceinline__ void swa_phase(const Params& p, LAS unsigned char* lds8, const int e) {
    unsigned char* ws = WSP();
    LAS unsigned short* Kb = (LAS unsigned short*)lds8; LAS unsigned short* VTb = Kb + KROWS * SW_KS; LAS float* biasT = (LAS float*)(VTb + 64 * SW_VS);
    const float* PROJ = (const float*)(ws + WS_PROJ);
    const float* cK = IN(3) + (size_t)e * 32 * 128 * 256; const float* cV = IN(4) + (size_t)e * 32 * 128 * 256;
    bf16_t* MA = (bf16_t*)(ws + WS_MA);
    const int tid = TID(), bid = BID(), gsz = GSZ(), lane = tid & 63, wave = rfl(tid >> 6), fr = lane & 15, fq = lane >> 4;
    for (int item = bid; item < 1024 + 128; item += gsz) {
        const bool samp = item >= 1024;
        int b, kh, q0 = 0;
        if (!samp) { b = item >> 9; kh = (item >> 7) & 3; q0 = (item & 127) * 32; } else { const int ii = item - 1024; b = ii >> 2; kh = ii & 3; }
        __syncthreads();
        for (int idx = tid; idx < KROWS * 16; idx += 512) {
            const int r = idx >> 4, c = (idx & 15) * 4;
            f32x4 kv = (f32x4){0.f, 0.f, 0.f, 0.f}, vv = kv;
            if (!samp) { const int pos = q0 - 127 + r; if (pos >= 0 && r < 159) { const float* src = PROJ + (size_t)(b * SEQ + pos) * IN_EVEN + 5120 + kh * 64 + c; kv = *(const f32x4*)src; vv = *(const f32x4*)(src + 256); } }
            else if (r < 128) { const size_t o_ = ((size_t)b * 128 + r) * 256 + kh * 64 + c; kv = *(const f32x4*)(cK + o_); vv = *(const f32x4*)(cV + o_); }
            else if (r < 136) { const float* src = PROJ + (size_t)(MP + b * DSEQ + r - 128) * IN_EVEN + 5120 + kh * 64 + c; kv = *(const f32x4*)src; vv = *(const f32x4*)(src + 256); }
            u32x2 kw; kw.x = pk2(kv[0], kv[1]); kw.y = pk2(kv[2], kv[3]); *(LAS u32x2*)(Kb + r * SW_KS + c) = kw;
            VTb[(c + 0) * SW_VS + r] = bf1(vv[0]); VTb[(c + 1) * SW_VS + r] = bf1(vv[1]); VTb[(c + 2) * SW_VS + r] = bf1(vv[2]); VTb[(c + 3) * SW_VS + r] = bf1(vv[3]);
        }
        { const int d = tid >> 2, hh = tid & 3; int bkt = d;
          if (d >= 16) { bkt = 16 + (int)(logf((float)d * 0.0625f) * (16.0f / 2.0794415416798357f)); bkt = bkt > 31 ? 31 : bkt; }
          biasT[tid] = IN(15)[bkt * 16 + kh * 4 + hh]; }
        __syncthreads();
        const int hh = wave >> 1, sub = wave & 1;
        const bool active = !samp || (sub == 0);
        if (active) {
            const int qi = 16 * sub + fr;
            const bool qreal = !samp || qi < 8;
            const int rq = samp ? 128 + qi : 127 + qi;
            const int mtok = samp ? MP + b * DSEQ + (qi & 7) : b * SEQ + q0 + qi;
            const int head = kh * 4 + hh;
            const float sink = IN(16)[e * 16 + head];
            bf16x8 qf[2];
            { const float* qp = PROJ + (size_t)mtok * IN_EVEN + 4096 + head * 64 + 8 * fq;
#pragma unroll
              for (int ks = 0; ks < 2; ++ks) { const f32x4 a = *(const f32x4*)(qp + 32 * ks) * 0.125f, c2 = *(const f32x4*)(qp + 32 * ks + 4) * 0.125f;
                  u32x4 w; w.x = pk2(a[0], a[1]); w.y = pk2(a[2], a[3]); w.z = pk2(c2[0], c2[1]); w.w = pk2(c2[2], c2[3]); qf[ks] = __builtin_bit_cast(bf16x8, w); } }
            const int kt0 = samp ? 0 : sub;
            f32x4 S[10]; float mloc = -1e30f;
#pragma unroll
            for (int t = 0; t < 10; ++t) {
                S[t] = (f32x4){0.f, 0.f, 0.f, 0.f};
                if (t < 9) {
#pragma unroll
                    for (int ks = 0; ks < 2; ++ks) { const bf16x8 a = *(const LAS bf16x8*)(Kb + (16 * (kt0 + t) + fr) * SW_KS + 32 * ks + 8 * fq);
                        S[t] = __builtin_amdgcn_mfma_f32_16x16x32_bf16(a, qf[ks], S[t], 0, 0, 0); }
                }
#pragma unroll
                for (int r = 0; r < 4; ++r) { const int R = 16 * (kt0 + t) + 4 * fq + r, d = rq - R;
                    const bool valid = (t < 9) && d >= 0 && d < 128 && (samp || (q0 - 127 + R >= 0));
                    const float sv = valid ? S[t][r] + biasT[(d & 127) * 4 + hh] : -1e30f;
                    S[t][r] = sv; mloc = fmaxf(mloc, sv); }
            }
            mloc = fmaxf(mloc, __shfl_xor(mloc, 16)); mloc = fmaxf(mloc, __shfl_xor(mloc, 32));
            const float mt = fmaxf(mloc, sink);
            float l = 0.f;
#pragma unroll
            for (int t = 0; t < 10; ++t)
#pragma unroll
                for (int r = 0; r < 4; ++r) { const float pp = __expf(S[t][r] - mt); S[t][r] = pp; l += pp; }
            l += __shfl_xor(l, 16); l += __shfl_xor(l, 32);
            const float inv = 1.f / (l + __expf(sink - mt));
            f32x4 O[4];
#pragma unroll
            for (int dt = 0; dt < 4; ++dt) O[dt] = (f32x4){0.f, 0.f, 0.f, 0.f};
#pragma unroll
            for (int s = 0; s < 5; ++s) {
                u32x4 pw; pw.x = pk2(S[2 * s][0], S[2 * s][1]); pw.y = pk2(S[2 * s][2], S[2 * s][3]); pw.z = pk2(S[2 * s + 1][0], S[2 * s + 1][1]); pw.w = pk2(S[2 * s + 1][2], S[2 * s + 1][3]);
                const bf16x8 pb = __builtin_bit_cast(bf16x8, pw);
#pragma unroll
                for (int dt = 0; dt < 4; ++dt) {
                    const LAS unsigned short* vp = VTb + (16 * dt + fr) * SW_VS + 16 * (kt0 + 2 * s) + 4 * fq;
                    const s16x4 v0 = *(const LAS s16x4*)vp; s16x4 v1 = (s16x4){0, 0, 0, 0}; if (s < 4) v1 = *(const LAS s16x4*)(vp + 16);
                    const bf16x8 a = (bf16x8){v0[0], v0[1], v0[2], v0[3], v1[0], v1[1], v1[2], v1[3]};
                    O[dt] = __builtin_amdgcn_mfma_f32_16x16x32_bf16(a, pb, O[dt], 0, 0, 0); }
            }
            if (qreal) {
                bf16_t* dst = MA + (size_t)mtok * D + 1024 + head * 64 + 4 * fq;
#pragma unroll
                for (int dt = 0; dt < 4; ++dt) { u32x2 w; w.x = pk2(O[dt][0] * inv, O[dt][1] * inv); w.y = pk2(O[dt][2] * inv, O[dt][3] * inv); *(u32x2*)(dst + 16 * dt) = w; }
            }
        }
    }
    const int gt = bid * 512 + tid, ngt = gsz * 512;
    for (int idx = gt; idx < 2 * 128 * 64; idx += ngt) {
        const int b = idx >> 13, w = (idx >> 6) & 127, c = (idx & 63) * 4;
        const float* src = PROJ + (size_t)(b * SEQ + SEQ - 128 + w) * IN_EVEN + 5120 + c;
        const size_t o_ = (((size_t)e * 2 + b) * 128 + w) * 256 + c;
        *(f32x4*)(OUTP() + OFF_KP + o_) = *(const f32x4*)src; *(f32x4*)(OUTP() + OFF_VP + o_) = *(const f32x4*)(src + 256);
    }
    for (int idx = gt; idx < 32 * 128 * 64; idx += ngt) {
        const int b = idx >> 13, w = (idx >> 6) & 127, c = (idx & 63) * 4;
        f32x4 kv, vv;
        if (w < 120) { const size_t s_ = ((size_t)b * 128 + w + 8) * 256 + c; kv = *(const f32x4*)(cK + s_); vv = *(const f32x4*)(cV + s_); }
        else { const float* src = PROJ + (size_t)(MP + b * DSEQ + w - 120) * IN_EVEN + 5120 + c; kv = *(const f32x4*)src; vv = *(const f32x4*)(src + 256); }
        const size_t o_ = (((size_t)e * 32 + b) * 128 + w) * 256 + c;
        *(f32x4*)(OUTP() + OFF_KS + o_) = kv; *(f32x4*)(OUTP() + OFF_VS + o_) = vv;
    }
}

__device__ __forceinline__ void put_job(LAS unsigned char* lds, int j, const void* A, const void* B, void* C, int nN, int ldc, int mode, int& start, int ks = 1, const void* bias = nullptr) {
    LAS pg8::Job* jb = (LAS pg8::Job*)(lds + JOBS_OFF) + j;
    asm volatile("" : "+s"(nN), "+s"(ldc), "+s"(mode), "+s"(ks));
    jb->A = (unsigned long long)A; jb->B = (unsigned long long)B; jb->C = (unsigned long long)C; jb->nN = nN; jb->ldc = ldc; jb->mode = mode; jb->start = start; jb->ks = ks; jb->pad = 0; jb->bias = (unsigned long long)bias;
    start += ks > 1 ? (M / 256 - 1) * nN + nN * ks : (M / 256) * nN;
}
enum { G_IN = 0, G_OUT = 1, G_UP = 2, G_DOWN = 3, G_RKV = 4, G_L2 = 5, G_WO = 6, MIX_E = 7, ROW_HG = 8, ROW_P1 = 9, MIX_O = 10, ROW_GN = 11, HG_H2 = 13, HG_H3 = 14 };

__device__ __forceinline__ int setup_jobs(const Params& p, LAS unsigned char* lds, int kind, int layer) {
    unsigned char* ws = WSP(); const bf16_t* WB = (const bf16_t*)(ws + WS_WB);
    const int o = layer >> 1;
    int K = 2048;
    if (TID() == 0) {
        int start = 0, nj = 0;
        const bf16_t* HB = (const bf16_t*)(ws + WS_HB); const bf16_t* MA = (const bf16_t*)(ws + WS_MA);
        if (kind == G_IN) put_job(lds, nj++, HB, WB + WB_WIN, ws + WS_PROJ, IN_EVEN / 256, IN_EVEN, 0, start);
        else if (kind == G_OUT) put_job(lds, nj++, MA, WB + WB_WOUT, ws + WS_MIX, 8, D, 1, start, KSPLIT);
        else if (kind == G_UP) put_job(lds, nj++, HB, WB + WB_UP, ws + WS_HID, 32, 8192, 2, start);
        else if (kind == G_DOWN) put_job(lds, nj++, ws + WS_HID, WB + WB_DOWN, ws + WS_MIX, 8, D, 1, start, KSPLIT);
        else if (kind == G_WO) put_job(lds, nj++, MA, WB + WB_WO, ws + WS_MIX, 8, D, 1, start, KSPLIT);
        else if (kind == G_RKV) {
            const bf16_t* XM = (const bf16_t*)(ws + WS_XMIX); const size_t MD = (size_t)M * D;
            put_job(lds, nj++, XM + 0 * MD, WB + WB_WR, ws + WS_R, 8, D, 0, start);
            put_job(lds, nj++, XM + 2 * MD, WB + WB_WK, ws + WS_K, 8, D, 0, start);
            put_job(lds, nj++, XM + 3 * MD, WB + WB_WV, ws + (o == 0 ? WS_VF : WS_V3), 8, D, 0, start);
            put_job(lds, nj++, XM + 1 * MD, WB + WB_L1 + 0 * 524288, ws + WS_MA + 0 * MID_BYTES, 1, 256, 3, start);
            put_job(lds, nj++, XM + 4 * MD, WB + WB_L1 + 1 * 524288, ws + WS_MA + 1 * MID_BYTES, 1, 256, 1, start);
            put_job(lds, nj++, XM + 5 * MD, WB + WB_L1 + 3 * 524288, ws + WS_MA + 3 * MID_BYTES, 1, 256, 4, start);
            if (o) put_job(lds, nj++, XM + 3 * MD, WB + WB_L1 + 2 * 524288, ws + WS_MA + 2 * MID_BYTES, 1, 256, 1, start);
        } else if (kind == G_L2) {
            put_job(lds, nj++, ws + WS_MA + 0 * MID_BYTES, WB + WB_L2 + 0 * 524288, ws + WS_W2O, 8, D, 5, start, 1, IN(22) + (size_t)o * D);
            put_job(lds, nj++, ws + WS_MA + 1 * MID_BYTES, WB + WB_L2 + 1 * 524288, ws + WS_A2O, 8, D, 6, start, 1, IN(25) + (size_t)o * D);
            put_job(lds, nj++, ws + WS_MA + 3 * MID_BYTES, WB + WB_L2 + 3 * 524288, ws + WS_HB, 8, D, 1, start);
            if (o) put_job(lds, nj++, ws + WS_MA + 2 * MID_BYTES, WB + WB_L2 + 2 * 524288, ws + WS_V2O, 8, D, 6, start, 1, IN(28) + (size_t)(o - 1) * D);
        }
        LAS int* hdr = (LAS int*)(lds + HDR_OFF); hdr[0] = nj; hdr[1] = start;
    }
    if (kind == G_DOWN) K = 8192;
    if (kind == G_L2) K = 256;
    return K;
}

__global__ void __launch_bounds__(512, 2) mega_fwd(Params p) {
    extern __shared__ __attribute__((aligned(16))) unsigned char lds_raw[];
    LAS unsigned char* lds = (LAS unsigned char*)lds_raw;
    cg::grid_group grid = cg::this_grid();
    unsigned* xbar = (unsigned*)(WSP() + WS_BAR);
    volatile LAS unsigned* xst = (volatile LAS unsigned*)(lds + LDS_BYTES - 16);
    if (threadIdx.x < 2) xst[threadIdx.x] = 0u;
    if (threadIdx.x == 0) (void)xb_add(&xbar[XB_XCNT(xb_xcc_id())], 1u);
    if (gridDim.x == 0) grid.sync();
    __syncthreads();
    unsigned char* ws = WSP();
    for (int layer = 0; layer <= 4; ++layer) {
#ifndef DBG_NO_CONV
        if (layer < 4) {
            bf16_t* WB = (bf16_t*)(ws + WS_WB);
            const int tid_ = TID(), lane = tid_ & 63, wave = rfl(tid_ >> 6), gw = BID() * 8 + wave, ngw = GSZ() * 8;
            LAS float* scr = (LAS float*)(lds + wave * 16384);
            const int o = layer >> 1, e = layer >> 1;
            conv_mat(IN(38) + (size_t)layer * 16777216, 2048, 8192, WB + WB_UP, 2048, 8192, scr, gw, ngw, lane);
            conv_mat(IN(39) + (size_t)layer * 16777216, 8192, 2048, WB + WB_DOWN, 8192, 2048, scr, gw, ngw, lane);
            if ((layer & 1) == 0) {
                conv_mat(IN(11) + (size_t)e * 2048 * IN_EVEN, 2048, IN_EVEN, WB + WB_WIN, 2048, IN_EVEN, scr, gw, ngw, lane);
                conv_mat(IN(12) + (size_t)e * 4194304, 2048, 2048, WB + WB_WOUT, 2048, 2048, scr, gw, ngw, lane);
            } else {
                conv_mat(IN(18) + (size_t)o * 4194304, 2048, 2048, WB + WB_WR, 2048, 2048, scr, gw, ngw, lane);
                conv_mat(IN(19) + (size_t)o * 4194304, 2048, 2048, WB + WB_WK, 2048, 2048, scr, gw, ngw, lane);
                conv_mat(IN(20) + (size_t)o * 4194304, 2048, 2048, WB + WB_WV, 2048, 2048, scr, gw, ngw, lane);
                conv_mat(IN(21) + (size_t)o * 4194304, 2048, 2048, WB + WB_WO, 2048, 2048, scr, gw, ngw, lane);
                conv_mat(IN(23) + (size_t)o * 2048 * 96, 2048, 96, WB + WB_L1 + 0 * 524288, 2048, 256, scr, gw, ngw, lane);
                conv_mat(IN(26) + (size_t)o * 2048 * 96, 2048, 96, WB + WB_L1 + 1 * 524288, 2048, 256, scr, gw, ngw, lane);
                conv_mat(IN(31) + (size_t)o * 2048 * 256, 2048, 256, WB + WB_L1 + 3 * 524288, 2048, 256, scr, gw, ngw, lane);
                conv_mat(IN(24) + (size_t)o * 96 * 2048, 96, 2048, WB + WB_L2 + 0 * 524288, 256, 2048, scr, gw, ngw, lane);
                conv_mat(IN(27) + (size_t)o * 96 * 2048, 96, 2048, WB + WB_L2 + 1 * 524288, 256, 2048, scr, gw, ngw, lane);
                conv_mat(IN(32) + (size_t)o * 256 * 2048, 256, 2048, WB + WB_L2 + 3 * 524288, 256, 2048, scr, gw, ngw, lane);
                if (o) {
                    conv_mat(IN(29) + (size_t)(o - 1) * 2048 * 64, 2048, 64, WB + WB_L1 + 2 * 524288, 2048, 256, scr, gw, ngw, lane);
                    conv_mat(IN(30) + (size_t)(o - 1) * 64 * 2048, 64, 2048, WB + WB_L2 + 2 * 524288, 256, 2048, scr, gw, ngw, lane);
                }
            }
        }
#endif
#ifndef DBG_NO_ROWPRE
        row_pre(p, layer);
#endif
        if (layer == 4) break;
        xcd_barrier(xbar, xst);
        const bool odd = layer & 1;
        const int nsub = odd ? 8 : 9;
        const unsigned long long seq = odd ? 0x3296BA54ull : 0x32918ED70ull;
        for (int sidx = 0; sidx < nsub; ++sidx) {
            const int kind = (int)((seq >> (4 * sidx)) & 15ull);
            if (kind <= G_WO) {
                __syncthreads();
                const int K = setup_jobs(p, lds, kind, layer);
                __syncthreads();
#ifndef DBG_NO_GEMM
                pg8::gemm_phase(lds, K, GSZ(), BID());
#endif
            } else if (kind == MIX_E) {
#ifndef DBG_NO_SCANE
                hgrn_h1(lds, layer >> 1);
                scan_phase<false>(p, lds, layer >> 1, 256);
#ifdef PROBE_DUP_SCAN
                __syncthreads();
                scan_phase<false>(p, lds, layer >> 1);
#endif
#endif
                __syncthreads();
#ifndef DBG_NO_SWA
                swa_phase(p, lds, layer >> 1);
#ifdef PROBE_DUP_SWA
                __syncthreads();
                swa_phase(p, lds, layer >> 1);
#endif
#endif
            } else if (kind == HG_H2) { hgrn_h2(layer >> 1);
            } else if (kind == HG_H3) { hgrn_h3(lds, layer >> 1);
            } else if (kind == ROW_HG) {
#ifndef DBG_NO_ROWHG
                row_hg(p, layer >> 1);
#endif
            } else if (kind == ROW_P1) {
#ifndef DBG_NO_ROWP1
                row_post1(p, layer);
#endif
            }
            else if (kind == MIX_O) {
#ifndef DBG_NO_SCANO
                scan_phase<true>(p, lds, layer >> 1);
#ifdef PROBE_DUP_SCAN
                __syncthreads();
                scan_phase<true>(p, lds, layer >> 1);
#endif
#endif
            }
            else {
#ifndef DBG_NO_ROWGN
                row_gn(p, layer);
#endif
            }
            xcd_barrier(xbar, xst);
        }
    }
}

extern "C" void kernel_launch(void* const* d_in, const int* in_sizes, int n_in, void* d_out, int out_size, void* d_ws, size_t ws_size, hipStream_t stream) {
    static int grid = 0;
    if (grid == 0) {
        if (n_in != 40 || ws_size < WS_END) { fprintf(stderr, "kernel_launch: unexpected n_in %d or ws_size %zu (< %zu)\n", n_in, ws_size, (size_t)WS_END); grid = -1; return; }
        int dev = 0, cus = 0, per_cu = 0;
        hipGetDevice(&dev);
        hipDeviceGetAttribute(&cus, hipDeviceAttributeMultiprocessorCount, dev);
        if (hipFuncSetAttribute((const void*)mega_fwd, hipFuncAttributeMaxDynamicSharedMemorySize, LDS_BYTES) != hipSuccess) { fprintf(stderr, "kernel_launch: hipFuncSetAttribute failed\n"); grid = -1; return; }
        hipOccupancyMaxActiveBlocksPerMultiprocessor(&per_cu, (const void*)mega_fwd, 512, LDS_BYTES);
        if (per_cu < 1) { fprintf(stderr, "kernel_launch: occupancy query says %d blocks/CU\n", per_cu); per_cu = 1; }
        (void)hipGetLastError();
        grid = cus;
    }
    if (grid < 0) return;
    Params p{};
    for (int i = 0; i < 40; ++i) p.in[i] = (const float*)d_in[i];
    p.out = (float*)d_out; p.ws = (unsigned char*)d_ws;
    if (hipMemsetAsync((char*)d_ws + WS_BAR, 0, XCD_BAR_WORDS * 4, stream) != hipSuccess) { fprintf(stderr, "kernel_launch: hipMemsetAsync of the barrier words failed\n"); return; }
    void* args[] = {&p};
    hipError_t e = hipLaunchCooperativeKernel((const void*)mega_fwd, dim3(grid), dim3(512), args, LDS_BYTES, stream);
    if (e != hipSuccess) fprintf(stderr, "kernel_launch: cooperative launch failed: %s (grid %d)\n", hipGetErrorString(e), grid);
}
```
